# Optimizing an MI355X kernel written in HIP

```python
import math
import jax, jax.numpy as jnp
from jax import lax
import numpy as np

D_MODEL = 1024
BATCH = 32
SEQ = 256
DEPTH = 1
DEC_BATCH = 4
DEC_SEQ = 2048
PAST_LEN = 512

GRID_W = 64
HEAD_DIM = 64
A_HEADS = 8
A_QK = A_HEADS * 2 * HEAD_DIM
A_V = A_HEADS * 2 * HEAD_DIM
B_HEADS = 16
B_KV_HEADS = 4
B_GROUP = B_HEADS // B_KV_HEADS
B_Q = B_HEADS * HEAD_DIM
B_KVW = B_KV_HEADS * HEAD_DIM
WINDOW = 128
BLOCK = 128
N_IN = 2 * A_QK + A_V + B_Q + 2 * B_KVW + 2 * D_MODEL
D_FF = 2816
N_MOD = 6
EPS = 1e-6
ROPE_BASE = 10000.0
NEG = -1e30

kernel_name = "hybrid_diffattn_window_sink_dit_step"


def _rmsnorm(x, g):
    xf = x.astype(jnp.float32)
    y = xf * lax.rsqrt(jnp.mean(xf * xf, axis=-1, keepdims=True) + EPS)
    return (y * g.astype(jnp.float32)).astype(x.dtype)


def _axial_rope(x):
    T = x.shape[1]
    rows = T // GRID_W
    row = jnp.repeat(jnp.arange(rows), GRID_W).astype(jnp.float32)
    col = jnp.tile(jnp.arange(GRID_W), rows).astype(jnp.float32)
    quarter = HEAD_DIM // 4
    freqs = ROPE_BASE ** (-jnp.arange(quarter, dtype=jnp.float32) / quarter)
    bshape = (1, T) + (1,) * (x.ndim - 3) + (quarter,)
    ang_r = (row[:, None] * freqs).reshape(bshape)
    ang_c = (col[:, None] * freqs).reshape(bshape)

    def rot(xh, ang):
        x1, x2 = xh[..., :quarter], xh[..., quarter:]
        cos, sin = jnp.cos(ang), jnp.sin(ang)
        return jnp.concatenate([x1 * cos - x2 * sin, x2 * cos + x1 * sin], axis=-1)

    xf = x.astype(jnp.float32)
    half = HEAD_DIM // 2
    out = jnp.concatenate([rot(xf[..., :half], ang_r), rot(xf[..., half:], ang_c)], axis=-1)
    return out.astype(x.dtype)


def _diff_attend(q, k, v, lam):
    B, T = q.shape[:2]
    nb = T // BLOCK
    qb = q.reshape(B, nb, BLOCK, A_HEADS, 2, HEAD_DIM).swapaxes(0, 1)
    scale = HEAD_DIM ** -0.5

    def one(qi):
        s = jnp.einsum("bqhcd,bkhcd->bhcqk", qi, k).astype(jnp.float32) * scale
        p = jax.nn.softmax(s, axis=-1)
        a = (p[:, :, 0] - lam * p[:, :, 1]).astype(v.dtype)
        return jnp.einsum("bhqk,bkhe->bqhe", a, v)

    out = lax.map(one, qb)
    return out.swapaxes(0, 1).reshape(B, T, A_HEADS, 2 * HEAD_DIM)


def _window_attend(q, k_ctx, v_ctx, sink, k_lat, v_lat):
    B, T = q.shape[:2]
    nb = T // BLOCK
    n_ctx = k_ctx.shape[1]
    scale = HEAD_DIM ** -0.5
    qb = q.reshape(B, nb, BLOCK, B_KV_HEADS, B_GROUP, HEAD_DIM).swapaxes(0, 1)
    sink_col = jnp.broadcast_to(sink.astype(jnp.float32).reshape(1, B_KV_HEADS, B_GROUP, 1, 1),
                                (B, B_KV_HEADS, B_GROUP, BLOCK, 1))
    local = k_lat is not None
    if local:
        pad = ((0, 0), (BLOCK, BLOCK), (0, 0), (0, 0))
        kpad = jnp.pad(k_lat, pad)
        vpad = jnp.pad(v_lat, pad)
        rel = jnp.arange(3 * BLOCK)[None, :] - BLOCK - jnp.arange(BLOCK)[:, None]
        band = jnp.abs(rel) <= WINDOW

    def one(args):
        i, qi = args
        s_ctx = jnp.einsum("bqgrd,bkgd->bgrqk", qi, k_ctx).astype(jnp.float32) * scale
        if local:
            kb = lax.dynamic_slice_in_dim(kpad, i * BLOCK, 3 * BLOCK, axis=1)
            vb = lax.dynamic_slice_in_dim(vpad, i * BLOCK, 3 * BLOCK, axis=1)
            s_loc = jnp.einsum("bqgrd,bkgd->bgrqk", qi, kb).astype(jnp.float32) * scale
            kpos = i * BLOCK - BLOCK + jnp.arange(3 * BLOCK)
            valid = band & ((kpos >= 0) & (kpos < T))[None, :]
            s_loc = jnp.where(valid, s_loc, NEG)
            p = jax.nn.softmax(jnp.concatenate([s_loc, s_ctx, sink_col], axis=-1), axis=-1)
            p = p.astype(v_ctx.dtype)
            n_loc = 3 * BLOCK
            out = (jnp.einsum("bgrqk,bkgd->bqgrd", p[..., :n_loc], vb)
                   + jnp.einsum("bgrqk,bkgd->bqgrd", p[..., n_loc:n_loc + n_ctx], v_ctx))
        else:
            p = jax.nn.softmax(jnp.concatenate([s_ctx, sink_col], axis=-1), axis=-1)
            p = p.astype(v_ctx.dtype)
            out = jnp.einsum("bgrqk,bkgd->bqgrd", p[..., :n_ctx], v_ctx)
        return out

    out = lax.map(one, (jnp.arange(nb), qb))
    return out.swapaxes(0, 1).reshape(B, T, B_HEADS, HEAD_DIM)


def _layer(x, mod, ctx_kv, lambda_init, norm1_g, w_in, qn_a, kn_a, lq1, lk1, lq2, lk2, subln_g,
           qn_b, kn_b, sink, w_oa, w_ob, w_out, norm2_g, w_gate, w_up, w_down):
    B, T = x.shape[:2]
    sh1, sc1, g1, sh2, sc2, g2 = jnp.split(mod, N_MOD, axis=-1)
    h = _rmsnorm(x, norm1_g) * (1 + sc1) + sh1
    proj = h @ w_in
    offs = list(np.cumsum([A_QK, A_QK, A_V, B_Q, B_KVW, B_KVW, D_MODEL]))
    qa, ka, va, qb, kb, vb, ga, gb = jnp.split(proj, offs, axis=-1)
    qa = _rmsnorm(qa.reshape(B, T, A_HEADS, 2, HEAD_DIM), qn_a)
    ka = _rmsnorm(ka.reshape(B, T, A_HEADS, 2, HEAD_DIM), kn_a)
    va = va.reshape(B, T, A_HEADS, 2 * HEAD_DIM)
    qb = _rmsnorm(qb.reshape(B, T, B_HEADS, HEAD_DIM), qn_b)
    kb = _rmsnorm(kb.reshape(B, T, B_KV_HEADS, HEAD_DIM), kn_b)
    vb = vb.reshape(B, T, B_KV_HEADS, HEAD_DIM)
    f32 = lambda a: a.astype(jnp.float32)
    lam = (jnp.exp(jnp.sum(f32(lq1) * f32(lk1))) - jnp.exp(jnp.sum(f32(lq2) * f32(lk2)))
           + lambda_init)
    if ctx_kv is None:
        oa = _diff_attend(qa, ka, va, lam)
        ob = _window_attend(qb, kb, vb, sink, None, None)
        new_kv = (ka, va, kb, vb)
    else:
        cka, cva, ckb, cvb = ctx_kv
        qa, ka, qb, kb = _axial_rope(qa), _axial_rope(ka), _axial_rope(qb), _axial_rope(kb)
        oa = _diff_attend(qa, jnp.concatenate([ka, cka], axis=1),
                          jnp.concatenate([va, cva], axis=1), lam)
        ob = _window_attend(qb, ckb, cvb, sink, kb, vb)
        new_kv = None
    oa = _rmsnorm(oa, subln_g) * (1.0 - lambda_init)
    oa = oa.reshape(B, T, A_V) @ w_oa
    ob = ob.reshape(B, T, B_Q) @ w_ob
    merged = jax.nn.sigmoid(ga) * oa + jax.nn.sigmoid(gb) * ob
    x = x + g1 * (merged @ w_out)
    h2 = _rmsnorm(x, norm2_g) * (1 + sc2) + sh2
    x = x + g2 * ((jax.nn.silu(h2 @ w_gate) * (h2 @ w_up)) @ w_down)
    return x, new_kv


def setup_inputs(seed: int = 0) -> dict:
    key = jax.random.key(seed)
    ks = jax.random.split(key, 32)
    n = lambda k, s: jax.random.normal(k, s, jnp.float32)
    gain = lambda k, s: 1.0 + 0.02 * n(k, s)
    L = DEPTH
    return {
        "x_prompt": n(ks[0], (BATCH, SEQ, D_MODEL)),
        "x_sample": n(ks[1], (DEC_BATCH, DEC_SEQ, D_MODEL)),
        "cache_diff_k": n(ks[2], (DEC_BATCH, L, PAST_LEN, A_HEADS, 2, HEAD_DIM)),
        "cache_diff_v": n(ks[3], (DEC_BATCH, L, PAST_LEN, A_HEADS, 2 * HEAD_DIM)),
        "cache_win_k": n(ks[4], (DEC_BATCH, L, PAST_LEN, B_KV_HEADS, HEAD_DIM)),
        "cache_win_v": n(ks[5], (DEC_BATCH, L, PAST_LEN, B_KV_HEADS, HEAD_DIM)),
        "c": n(ks[6], (DEC_BATCH, D_MODEL)),
        "c_ctx": n(ks[7], (D_MODEL,)),
        "w_ada": 0.3 * D_MODEL ** -0.5 * n(ks[8], (L, D_MODEL, N_MOD * D_MODEL)),
        "b_ada": 0.02 * n(ks[9], (L, N_MOD * D_MODEL)),
        "norm1_g": gain(ks[10], (L, D_MODEL)),
        "w_in": D_MODEL ** -0.5 * n(ks[11], (L, D_MODEL, N_IN)),
        "qn_a": gain(ks[12], (L, HEAD_DIM)),
        "kn_a": gain(ks[13], (L, HEAD_DIM)),
        "lambda_q1": 0.1 * n(ks[14], (L, HEAD_DIM)),
        "lambda_k1": 0.1 * n(ks[15], (L, HEAD_DIM)),
        "lambda_q2": 0.1 * n(ks[16], (L, HEAD_DIM)),
        "lambda_k2": 0.1 * n(ks[17], (L, HEAD_DIM)),
        "subln_g": gain(ks[18], (L, 2 * HEAD_DIM)),
        "qn_b": gain(ks[19], (L, HEAD_DIM)),
        "kn_b": gain(ks[20], (L, HEAD_DIM)),
        "sink": 0.5 * n(ks[21], (L, B_HEADS)),
        "w_oa": A_V ** -0.5 * n(ks[22], (L, A_V, D_MODEL)),
        "w_ob": B_Q ** -0.5 * n(ks[23], (L, B_Q, D_MODEL)),
        "w_out": D_MODEL ** -0.5 * n(ks[24], (L, D_MODEL, D_MODEL)),
        "norm2_g": gain(ks[25], (L, D_MODEL)),
        "w_gate": D_MODEL ** -0.5 * n(ks[26], (L, D_MODEL, D_FF)),
        "w_up": D_MODEL ** -0.5 * n(ks[27], (L, D_MODEL, D_FF)),
        "w_down": D_FF ** -0.5 * n(ks[28], (L, D_FF, D_MODEL)),
    }


def reference(x_prompt, x_sample, cache_diff_k, cache_diff_v, cache_win_k, cache_win_v, c, c_ctx,
              w_ada, b_ada, norm1_g, w_in, qn_a, kn_a, lambda_q1, lambda_k1, lambda_q2, lambda_k2,
              subln_g, qn_b, kn_b, sink, w_oa, w_ob, w_out, norm2_g, w_gate, w_up, w_down):
    xp, xs = x_prompt, x_sample
    dk, dv, wk, wv = [], [], [], []
    for l in range(DEPTH):
        lambda_init = 0.8 - 0.6 * math.exp(-0.3 * l)
        mod_ctx = (jax.nn.silu(c_ctx) @ w_ada[l] + b_ada[l])[None, None, :]
        mod_lat = (jax.nn.silu(c) @ w_ada[l] + b_ada[l])[:, None, :]
        wts = (lambda_init, norm1_g[l], w_in[l], qn_a[l], kn_a[l], lambda_q1[l], lambda_k1[l],
               lambda_q2[l], lambda_k2[l], subln_g[l], qn_b[l], kn_b[l], sink[l], w_oa[l], w_ob[l],
               w_out[l], norm2_g[l], w_gate[l], w_up[l], w_down[l])
        xp, kv = _layer(xp, mod_ctx, None, *wts)
        dk.append(kv[0]); dv.append(kv[1]); wk.append(kv[2]); wv.append(kv[3])
        ctx = (cache_diff_k[:, l], cache_diff_v[:, l], cache_win_k[:, l], cache_win_v[:, l])
        xs, _ = _layer(xs, mod_lat, ctx, *wts)
    new_diff_k = jnp.stack(dk, axis=1)
    new_diff_v = jnp.stack(dv, axis=1)
    new_win_k = jnp.stack(wk, axis=1)
    new_win_v = jnp.stack(wv, axis=1)
    return (xp, xs, new_diff_k, new_diff_v, new_win_k, new_win_v)
```

```cpp
#include <hip/hip_runtime.h>
#include <hip/hip_cooperative_groups.h>
#include <cstdio>
#include <cstdint>
namespace cg = cooperative_groups;
namespace pg8 {
#define PG8_LAS __attribute__((address_space(3)))
typedef unsigned short bf16_t;
typedef short bf16x8 __attribute__((ext_vector_type(8)));
typedef float f32x4 __attribute__((ext_vector_type(4)));
typedef unsigned u32x4 __attribute__((ext_vector_type(4)));
constexpr int BM = 256, BK = 64, HALF = 128, HTB = HALF * BK * 2  , STAGE_BYTES = 8 * HTB, NXCD = 8, WGM = 8;

__host__ __device__ __forceinline__ int lds_byte(int r, int c) { const int st = (r >> 4) * 2 + (c >> 5), rr = r & 15, cc = c & 31, ob = rr * 64 + cc * 2; return st * 1024 + (ob ^ (((ob >> 9) & 1) << 5)); }
__host__ __device__ __forceinline__ void stage_rc(int b, int& R, int& C) { const int st = b / 1024, sb = b % 1024, swz = sb ^ (((sb >> 9) & 1) << 5); R = (st >> 1) * 16 + swz / 64; C = (st & 1) * 32 + (swz % 64) / 2; }
__host__ __device__ __forceinline__ int perm32(int rho) { const int n = rho >> 4, i = rho & 15; return 8 * (i >> 2) + 4 * n + (i & 3); }

struct Unit { int pm, pn; };
struct Gemm { const bf16_t* A; const bf16_t* Bt; int M, N, K; };

struct StaticOrder {
    int nM, nN, nwg, G, c;
    __host__ __device__ void init(int M, int N, int G_, int c_) { nM = M / BM; nN = N / BM; nwg = nM * nN; G = G_; c = c_; }
    __host__ __device__ bool next(int i, Unit& u) const {
        const long L = (long)i * G + c; if (L >= nwg) return false;
        int wgid = (int)L; { const int q = nwg / NXCD, r = nwg % NXCD, xcd = wgid % NXCD, off = wgid / NXCD; wgid = (xcd < r ? xcd * (q + 1) : r * (q + 1) + (xcd - r) * q) + off; }
        const int nig = WGM * nN, gid = wgid / nig, fm = gid * WGM, gsz = (nM - fm) < WGM ? (nM - fm) : WGM;
        u.pm = fm + ((wgid % nig) % gsz); u.pn = (wgid % nig) / gsz; return true;
    }
    __device__ __forceinline__ void a_ready(const Unit&) const {}
    __device__ __forceinline__ void done(const Unit&) const {}
};

__device__ __forceinline__ unsigned cvt_pk_bf16(float lo, float hi) { unsigned r; asm volatile("v_cvt_pk_bf16_f32 %0, %1, %2" : "=v"(r) : "v"(lo), "v"(hi)); return r; }

template <class Epi, class Sched, bool ALIGN_EPI = false, bool SP2 = false>
__device__ __forceinline__ void gemm_phase(PG8_LAS unsigned char* lds, const Gemm g, const Sched& S, const Epi& E) {
    int tid = threadIdx.x; asm volatile("" : "+v"(tid));
    const int wid = __builtin_amdgcn_readfirstlane(tid >> 6), lane = tid & 63, wr = wid >> 2, wc = wid & 3, fr = lane & 15, fq = lane >> 4;
    const int K = g.K, nt = K / BK;
    unsigned voffA[2], voffB[2];
#pragma unroll
    for (int i = 0; i < 2; ++i) { int R, C; stage_rc(tid * 16 + i * 8192, R, C); const int Rb = Epi::PERM ? ((R & ~31) + perm32(R & 31)) : R;
        voffA[i] = (unsigned)(R * K + C) * 2u; voffB[i] = (unsigned)(Rb * K + C) * 2u; }
    const size_t kstep = (size_t)(BK * 2);
    const size_t hstep = (size_t)HALF * K * 2;
    const size_t tstep = 2 * hstep;
    const unsigned ldsw = (unsigned)wid * 1024u;
    const int aoff = lds_byte(wr * 64 + fr, fq * 8), boff = lds_byte(wc * 32 + fr, fq * 8);
#define PG8_SA(b, h) (((b) * 2 + (h)) * HTB)
#define PG8_SB(b, h) ((4 + (b) * 2 + (h)) * HTB)
#define PG8_STAGE(bufoff, gbase, voff) do { _Pragma("unroll") for (int _i = 0; _i < 2; ++_i) \
        __builtin_amdgcn_global_load_lds((const unsigned*)((const char*)(gbase) + (voff)[_i]), (PG8_LAS unsigned*)(lds + (bufoff) + ldsw + _i * 8192), 16, 0, 0); } while (0)
#define PG8_LDA(dst, b, h) do { _Pragma("unroll") for (int m = 0; m < 4; ++m) _Pragma("unroll") for (int k = 0; k < 2; ++k) dst[m][k] = *(const PG8_LAS bf16x8*)(lds + PG8_SA(b, h) + aoff + m * 2048 + k * 1024); } while (0)
#define PG8_LDB(dst, b, h) do { _Pragma("unroll") for (int n = 0; n < 2; ++n) _Pragma("unroll") for (int k = 0; k < 2; ++k) dst[n][k] = *(const PG8_LAS bf16x8*)(lds + PG8_SB(b, h) + boff + n * 2048 + k * 1024); } while (0)
#define PG8_MMA(ai, bj, At, Bt) do { __builtin_amdgcn_s_setprio(1); _Pragma("unroll") for (int m = 0; m < 4; ++m) _Pragma("unroll") for (int n = 0; n < 2; ++n) _Pragma("unroll") for (int k = 0; k < 2; ++k) \
        acc[ai][bj][m][n] = __builtin_amdgcn_mfma_f32_16x16x32_bf16(Bt[n][k], At[m][k], acc[ai][bj][m][n], 0, 0, 0); __builtin_amdgcn_s_setprio(0); } while (0)
#define PG8_WAIT_V(n) asm volatile("s_waitcnt vmcnt(" #n ")" ::: "memory")
#define PG8_WAIT_L(n) asm volatile("s_waitcnt lgkmcnt(" #n ")" ::: "memory")
#define PG8_BAR __builtin_amdgcn_s_barrier()
#define PG8_SCHED __builtin_amdgcn_sched_barrier(0)
    Unit cur, nxt; int ui = 0;
    if (!S.next(0, cur)) return;
    f32x4 acc[2][2][4][2];
#pragma unroll
    for (int a = 0; a < 2; ++a)
#pragma unroll
        for (int b = 0; b < 2; ++b)
#pragma unroll
            for (int m = 0; m < 4; ++m)
#pragma unroll
                for (int n = 0; n < 2; ++n) acc[a][b][m][n] = (f32x4){0.f, 0.f, 0.f, 0.f};
    bf16x8 At[4][2], B0[2][2], B1[2][2];
    const char* cA = (const char*)g.A + (size_t)cur.pm * tstep; const char* cB = (const char*)g.Bt + (size_t)cur.pn * tstep;
    S.a_ready(cur);
    if constexpr (SP2) {
        PG8_STAGE(PG8_SB(0, 0), cB, voffB); PG8_STAGE(PG8_SB(0, 1), cB + hstep, voffB); PG8_STAGE(PG8_SA(0, 0), cA, voffA); PG8_STAGE(PG8_SA(0, 1), cA + hstep, voffA);
        if (wr == 1) PG8_BAR;
        PG8_WAIT_V(2); PG8_BAR;
        PG8_STAGE(PG8_SB(1, 0), cB + kstep, voffB); PG8_STAGE(PG8_SA(1, 0), cA + kstep, voffA); PG8_STAGE(PG8_SB(1, 1), cB + hstep + kstep, voffB);
        PG8_WAIT_V(6); PG8_BAR;
    } else {
        PG8_STAGE(PG8_SB(0, 0), cB, voffB); PG8_STAGE(PG8_SA(0, 0), cA, voffA); PG8_STAGE(PG8_SB(0, 1), cB + hstep, voffB); PG8_STAGE(PG8_SA(0, 1), cA + hstep, voffA);
        if (wr == 1) PG8_BAR;
        PG8_WAIT_V(4); PG8_BAR;
        PG8_STAGE(PG8_SB(1, 0), cB + kstep, voffB); PG8_STAGE(PG8_SA(1, 0), cA + kstep, voffA); PG8_STAGE(PG8_SB(1, 1), cB + hstep + kstep, voffB);
        PG8_WAIT_V(6); PG8_BAR;
    }
    for (;;) {
        const bool has_next = S.next(ui + 1, nxt);
        const char* nA = has_next ? (const char*)g.A + (size_t)nxt.pm * tstep : cA; const char* nB = has_next ? (const char*)g.Bt + (size_t)nxt.pn * tstep : cB;
        for (int t = 0; t < nt; t += 2) {
            const bool last = (t == nt - 2);
            const char* a1 = cA + (size_t)(t + 1) * kstep;
            const char* a2 = last ? nA : cA + (size_t)(t + 2) * kstep; const char* b2 = last ? nB : cB + (size_t)(t + 2) * kstep;
            const char* a3 = a2 + kstep; const char* b3 = b2 + kstep;
            if (last && has_next) S.a_ready(nxt);
            if constexpr (SP2) {
            PG8_LDB(B0, 0, 0); PG8_LDB(B1, 0, 1); PG8_SCHED; PG8_LDA(At, 0, 0); PG8_STAGE(PG8_SA(1, 1), a1 + hstep, voffA);
            PG8_WAIT_V(8); PG8_WAIT_L(0); PG8_BAR; PG8_MMA(0, 0, At, B0); PG8_MMA(0, 1, At, B1); PG8_BAR; PG8_SCHED;
            PG8_LDA(At, 0, 1); PG8_STAGE(PG8_SB(0, 0), b2, voffB); PG8_STAGE(PG8_SB(0, 1), b2 + hstep, voffB); PG8_STAGE(PG8_SA(0, 0), a2, voffA);
            PG8_WAIT_V(8); PG8_WAIT_L(0); PG8_BAR; PG8_MMA(1, 0, At, B0); PG8_MMA(1, 1, At, B1); PG8_BAR; PG8_SCHED;
            PG8_LDB(B0, 1, 0); PG8_LDB(B1, 1, 1); PG8_SCHED; PG8_LDA(At, 1, 0); PG8_STAGE(PG8_SA(0, 1), a2 + hstep, voffA);
            PG8_WAIT_V(8); PG8_WAIT_L(0); PG8_BAR; PG8_MMA(0, 0, At, B0); PG8_MMA(0, 1, At, B1); PG8_BAR; PG8_SCHED;
            PG8_LDA(At, 1, 1); PG8_STAGE(PG8_SB(1, 0), b3, voffB); PG8_STAGE(PG8_SB(1, 1), b3 + hstep, voffB); PG8_STAGE(PG8_SA(1, 0), a3, voffA);
            PG8_WAIT_V(8); PG8_WAIT_L(0); PG8_BAR; PG8_MMA(1, 0, At, B0); PG8_MMA(1, 1, At, B1); PG8_BAR; PG8_SCHED;
            } else {
            PG8_LDB(B0, 0, 0); PG8_SCHED; PG8_LDA(At, 0, 0); PG8_STAGE(PG8_SA(1, 1), a1 + hstep, voffA);
            PG8_WAIT_L(8); PG8_BAR; PG8_WAIT_L(0); PG8_MMA(0, 0, At, B0); PG8_BAR; PG8_SCHED;
            PG8_LDB(B1, 0, 1); PG8_STAGE(PG8_SB(0, 0), b2, voffB);
            PG8_BAR; PG8_WAIT_L(0); PG8_MMA(0, 1, At, B1); PG8_BAR;
            PG8_LDA(At, 0, 1); PG8_STAGE(PG8_SA(0, 0), a2, voffA);
            PG8_BAR; PG8_WAIT_L(0); PG8_MMA(1, 0, At, B0); PG8_BAR; PG8_SCHED;
            PG8_STAGE(PG8_SB(0, 1), b2 + hstep, voffB);
            PG8_WAIT_V(6); PG8_BAR; PG8_MMA(1, 1, At, B1); PG8_BAR;
            PG8_LDB(B0, 1, 0); PG8_SCHED; PG8_LDA(At, 1, 0); PG8_STAGE(PG8_SA(0, 1), a2 + hstep, voffA);
            PG8_WAIT_L(8); PG8_BAR; PG8_WAIT_L(0); PG8_MMA(0, 0, At, B0); PG8_BAR; PG8_SCHED;
            PG8_LDB(B1, 1, 1); PG8_STAGE(PG8_SB(1, 0), b3, voffB);
            PG8_BAR; PG8_WAIT_L(0); PG8_MMA(0, 1, At, B1); PG8_BAR;
            PG8_LDA(At, 1, 1); PG8_STAGE(PG8_SA(1, 0), a3, voffA);
            PG8_BAR; PG8_WAIT_L(0); PG8_MMA(1, 0, At, B0); PG8_BAR; PG8_SCHED;
            PG8_STAGE(PG8_SB(1, 1), b3 + hstep, voffB);
            PG8_WAIT_V(6); PG8_BAR; PG8_MMA(1, 1, At, B1); PG8_BAR;
            }
        }
        if constexpr (ALIGN_EPI) { if (wr == 0) PG8_BAR; }
        if constexpr (!Epi::AFTER_DRAIN) { E(acc, cur, wr, wc, fr, fq); S.done(cur); }
        if (!has_next) break;
#pragma unroll
        for (int a = 0; a < 2; ++a)
#pragma unroll
            for (int b = 0; b < 2; ++b)
#pragma unroll
                for (int m = 0; m < 4; ++m)
#pragma unroll
                    for (int n = 0; n < 2; ++n) acc[a][b][m][n] = (f32x4){0.f, 0.f, 0.f, 0.f};
        cur = nxt; cA = nA; cB = nB; ++ui;
        if constexpr (ALIGN_EPI) { if (wr == 1) PG8_BAR; }
    }
    PG8_WAIT_V(0);
    if constexpr (!ALIGN_EPI) { if (wr == 0) PG8_BAR; }
    PG8_BAR;
    if constexpr (Epi::AFTER_DRAIN) { E.fused(acc, cur, wr, wc, fr, fq, lds, wid, lane); S.done(cur); }
#undef PG8_SA
#undef PG8_SB
#undef PG8_STAGE
#undef PG8_LDA
#undef PG8_LDB
#undef PG8_MMA
#undef PG8_WAIT_V
#undef PG8_WAIT_L
#undef PG8_BAR
#undef PG8_SCHED
}
}

using pg8::bf16_t; using pg8::bf16x8; using pg8::f32x4; using pg8::u32x4; using pg8::Unit;
#define LAS __attribute__((address_space(3)))
typedef float f32x16 __attribute__((ext_vector_type(16)));
typedef short s16x4 __attribute__((ext_vector_type(4)));
typedef float f32x2_t __attribute__((ext_vector_type(2)));
typedef __bf16 bf16x2_t __attribute__((ext_vector_type(2)));
typedef unsigned u32x2 __attribute__((ext_vector_type(2)));
typedef short v4i16_t __attribute__((ext_vector_type(4)));

#define DI __device__ __forceinline__
DI unsigned pk2(float lo, float hi) { f32x2_t v = {lo, hi}; bf16x2_t b = __builtin_convertvector(v, bf16x2_t); return __builtin_bit_cast(unsigned, b); }
DI float bflo(unsigned u) { return __uint_as_float(u << 16); }
DI float bfhi(unsigned u) { return __uint_as_float(u & 0xffff0000u); }
DI float wave_sum(float v) {
#pragma unroll
    for (int o = 1; o < 64; o <<= 1) v += __shfl_xor(v, o);
    return v;
}
DI float sigmoidf_(float v) { return __builtin_amdgcn_rcpf(1.f + __builtin_amdgcn_exp2f(-1.4426950408889634f * v)); }
#define MFMA32(a, b, c) __builtin_amdgcn_mfma_f32_32x32x16_bf16((a), (b), (c), 0, 0, 0)
DI s16x4 vtr(const LAS unsigned char* p) { return __builtin_bit_cast(s16x4, __builtin_amdgcn_ds_read_tr16_b64_v4i16((LAS v4i16_t*)p)); }

constexpr int M = 16384, D = 1024, NIN = 6656, FF = 2816, MP = 8192;
constexpr float EPS = 1e-6f;
constexpr float C2 = 0.125f * 1.4426950408889634f;
constexpr float LOG2E = 1.4426950408889634f;
constexpr size_t MiB = 1u << 20;
constexpr size_t WS_MOD = 0, WS_ROPE = 128 * 1024, WS_LAM = 256 * 1024, WS_GAIN = 260 * 1024, WS_BAR = 512 * 1024;
constexpr size_t WS_WIN = 1 * MiB, WS_WOA = 14 * MiB, WS_WOB = 16 * MiB, WS_WOUT = 18 * MiB, WS_WGU = 20 * MiB, WS_WDN = 31 * MiB;
constexpr size_t WS_H = 37 * MiB, WS_QA = 69 * MiB, WS_QB = 101 * MiB, WS_KA = 133 * MiB, WS_VA = 169 * MiB, WS_KB = 205 * MiB, WS_VB = 214 * MiB;
constexpr size_t WS_T1 = WS_KA, WS_ACT = WS_KA, WS_END = 223 * MiB;
constexpr int LDS_BYTES = 147456;
constexpr size_t O_YS = 0, O_DK = 16777216, O_DV = 25165824, O_WK = 33554432, O_WV = 35651584;

struct Params {
    const float *x_prompt, *x_sample, *cdk, *cdv, *cwk, *cwv, *c, *c_ctx, *w_ada, *b_ada, *norm1_g, *w_in, *qn_a, *kn_a, *lq1, *lk1, *lq2, *lk2,
        *subln_g, *qn_b, *kn_b, *sink, *w_oa, *w_ob, *w_out, *norm2_g, *w_gate, *w_up, *w_down;
    float* out; unsigned char* ws;
};

DI void p0_mod_task(const Params& p, int task, LAS unsigned char* lds, int tid) {
    float* mod = (float*)(p.ws + WS_MOD);
    if (task < 192) {
        LAS float* s = (LAS float*)lds;
        LAS float* red = (LAS float*)(lds + 20480);
        for (int i = tid; i < 5 * 1024; i += 512) { const int r = i >> 10, k = i & 1023; const float v = r == 0 ? p.c_ctx[k] : p.c[(r - 1) * 1024 + k]; s[i] = v / (1.f + expf(-v)); }
        __syncthreads();
        const int ks = tid >> 5, col = tid & 31; const float* w = p.w_ada + task * 32 + col;
        float a0 = 0.f, a1 = 0.f, a2 = 0.f, a3 = 0.f, a4 = 0.f;
#pragma unroll 8
        for (int i = 0; i < 64; ++i) { const int k = ks + 16 * i; const float wv = w[(size_t)k * 6144];
            a0 += s[k] * wv; a1 += s[1024 + k] * wv; a2 += s[2048 + k] * wv; a3 += s[3072 + k] * wv; a4 += s[4096 + k] * wv; }
        red[(ks * 5 + 0) * 32 + col] = a0; red[(ks * 5 + 1) * 32 + col] = a1; red[(ks * 5 + 2) * 32 + col] = a2; red[(ks * 5 + 3) * 32 + col] = a3; red[(ks * 5 + 4) * 32 + col] = a4;
        __syncthreads();
        if (tid < 160) { const int r = tid >> 5, cc = tid & 31; float t = 0.f;
#pragma unroll
            for (int j = 0; j < 16; ++j) t += red[(j * 5 + r) * 32 + cc];
            mod[r * 6144 + task * 32 + cc] = t + p.b_ada[task * 32 + cc]; }
        __syncthreads();
    } else {
        float* tab = (float*)(p.ws + WS_ROPE);
        for (int i = tid; i < 1024; i += 512) { const int pos = i >> 4, j = i & 15; const float freq = powf(10000.f, -(float)j / 16.f); const float ang = (float)pos * freq; tab[i] = cosf(ang); tab[1024 + i] = sinf(ang); }
        if (tid < 256) { const int ty = tid >> 6, j = tid & 63; float* gt = (float*)(p.ws + WS_GAIN);
            gt[tid] = ty == 0 ? p.qn_a[j] * C2 : ty == 1 ? p.kn_a[j] : ty == 2 ? p.qn_b[j] * C2 : p.kn_b[j]; }
        if (tid < 64) { float a = p.lq1[tid] * p.lk1[tid], b = p.lq2[tid] * p.lk2[tid]; a = wave_sum(a); b = wave_sum(b); if (tid == 0) *(float*)(p.ws + WS_LAM) = expf(a) - expf(b) + 0.2f; }
    }
}
DI int wrow_map(int mode, int n) {
    if (mode == 1) { const int L = n & 255; return (n & ~255) + 128 * ((L >> 4) & 1) + 32 * (L >> 6) + 8 * ((L >> 2) & 3) + 4 * ((L >> 5) & 1) + (L & 3); }
    if (mode == 5) { const int L = n & 31; return (n & ~31) + 8 * ((L >> 2) & 3) + 4 * ((L >> 4) & 1) + (L & 3); }
    if (mode == 2) return 256 * (n >> 7) + (n & 127);
    if (mode == 3) return 256 * (n >> 7) + 128 + (n & 127);
    return n;
}
DI void transpose_item(const float* W, int K, int N, bf16_t* WT, int mode, LAS float* scr, int item, int lane) {
    const int nblk = N / 32, kb = item / nblk, nb = item % nblk, k0 = 64 * kb, n0 = 32 * nb;
    if (mode < 0) mode = (n0 < 2048 || (n0 >= 3072 && n0 < 4352)) ? 1 : 0;
#pragma unroll 8
    for (int i = 0; i < 32; ++i) { const int kk = 2 * i + (lane >> 5); scr[kk * 33 + (lane & 31)] = W[(size_t)(k0 + kk) * N + n0 + (lane & 31)]; }
    asm volatile("s_waitcnt lgkmcnt(0)" ::: "memory");
    const int c = lane & 7;
#pragma unroll
    for (int j = 0; j < 4; ++j) { const int n = (lane >> 3) + 8 * j; const LAS float* s = scr + (8 * c) * 33 + n;
        u32x4 o; o.x = pk2(s[0 * 33], s[1 * 33]); o.y = pk2(s[2 * 33], s[3 * 33]); o.z = pk2(s[4 * 33], s[5 * 33]); o.w = pk2(s[6 * 33], s[7 * 33]);
        *(u32x4*)(WT + (size_t)wrow_map(mode, n0 + n) * K + k0 + 8 * c) = o; }
    asm volatile("s_waitcnt lgkmcnt(0)" ::: "memory");
}
DI void convert_span(const float* src, bf16_t* dst, int n4, int gtid, int nthr) {
    for (int i = gtid; i < n4; i += nthr) { const f32x4 v = ((const f32x4*)src)[i]; u32x2 o; o.x = pk2(v.x, v.y); o.y = pk2(v.z, v.w); ((u32x2*)dst)[i] = o; }
}
DI void convert_span_perm(const float* src, bf16_t* dst, int n4, int gtid, int nthr) {
    for (int i = gtid; i < n4; i += nthr) { const f32x4 v = ((const f32x4*)src)[i]; u32x2 o; o.x = pk2(v.x, v.y); o.y = pk2(v.z, v.w);
        const int e0 = 4 * i, d0 = e0 & 63, pp = 32 * ((d0 >> 4) & 1) + 8 * ((d0 >> 2) & 3) + 4 * ((d0 >> 5) & 1);
        *(u32x2*)(dst + (e0 - d0) + pp) = o; }
}
DI void norm_rows(const float* xa, const float* xb, const float* gain, const float* mod, int sh_off, int sc_off, bf16_t* out, int gw, int ngw, int lane) {
    for (int m = gw; m < M; m += ngw) {
        const float* xr = m < MP ? xa + (size_t)m * D : xb + (size_t)(m - MP) * D;
        const float* md = mod + (m < MP ? 0 : 1 + ((m - MP) >> 11)) * 6144;
        f32x4 v[4]; float ss = 0.f;
#pragma unroll
        for (int j = 0; j < 4; ++j) { v[j] = *(const f32x4*)(xr + 4 * lane + 256 * j); ss += (v[j].x * v[j].x + v[j].y * v[j].y) + (v[j].z * v[j].z + v[j].w * v[j].w); }
        const float rstd = rsqrtf(wave_sum(ss) * (1.f / D) + EPS);
#pragma unroll
        for (int j = 0; j < 4; ++j) { const int col = 4 * lane + 256 * j;
            const f32x4 g = *(const f32x4*)(gain + col), sc = *(const f32x4*)(md + sc_off + col), sh = *(const f32x4*)(md + sh_off + col);
            const f32x4 y = v[j] * rstd * g * (sc + 1.0f) + sh;
            u32x2 o; o.x = pk2(y.x, y.y); o.y = pk2(y.z, y.w); *(u32x2*)(out + (size_t)m * D + col) = o; }
    }
}

struct EpiIn {
    static constexpr bool PERM = true, AFTER_DRAIN = false;
    unsigned char* ws; float* out;
    DI void operator()(const f32x4 (&acc)[2][2][4][2], const Unit& u, int wr, int wc, int fr, int fq) const {
        asm volatile("" : "+v"(fr), "+v"(fq));
        const int pn = u.pn, pm = u.pm; const bool prompt = pm < 32;
        bf16_t *QA = (bf16_t*)(ws + WS_QA), *KA = (bf16_t*)(ws + WS_KA), *VA = (bf16_t*)(ws + WS_VA), *QB = (bf16_t*)(ws + WS_QB), *KB = (bf16_t*)(ws + WS_KB), *VB = (bf16_t*)(ws + WS_VB), *G = (bf16_t*)out;
        float *o_dk = out + O_DK, *o_dv = out + O_DV, *o_wk = out + O_WK, *o_wv = out + O_WV;
        const float* rope = (const float*)(ws + WS_ROPE); const float* gains = (const float*)(ws + WS_GAIN);
        int kvrow0, t0;
        if (prompt) { kvrow0 = pm * 256; t0 = 0; } else { const int sm = pm - 32; t0 = (sm & 7) * 256; kvrow0 = MP + (sm >> 3) * 2560 + t0; }
        const size_t m0 = (size_t)pm * 256;
        if (pn < 8 || (pn >= 12 && pn < 17)) {
            const float* gain; bf16_t* dst; int dstS; float* fo = nullptr; int foS = 0;
            if (pn < 4) { gain = gains; dst = QA + m0 * 1024 + pn * 256; dstS = 1024; }
            else if (pn < 8) { gain = gains + 64; dst = KA + (size_t)kvrow0 * 1024 + (pn - 4) * 256; dstS = 1024; if (prompt) { fo = o_dk + m0 * 1024 + (pn - 4) * 256; foS = 1024; } }
            else if (pn < 16) { gain = gains + 128; dst = QB + m0 * 1024 + (pn - 12) * 256; dstS = 1024; }
            else { gain = gains + 192; dst = KB + (size_t)kvrow0 * 256; dstS = 256; if (prompt) { fo = o_wk + m0 * 256; foS = 256; } }
            f32x4 gv[2][2];
#pragma unroll
            for (int bj = 0; bj < 2; ++bj)
#pragma unroll
                for (int n = 0; n < 2; ++n) gv[bj][n] = *(const f32x4*)(gain + 32 * n + 16 * bj + 4 * fq);
            float rstd8[8];
#pragma unroll
            for (int ai = 0; ai < 2; ++ai)
#pragma unroll
                for (int m = 0; m < 4; ++m) { float ss = 0.f;
#pragma unroll
                    for (int bj = 0; bj < 2; ++bj)
#pragma unroll
                        for (int n = 0; n < 2; ++n) { const f32x4 t = acc[ai][bj][m][n]; ss += (t.x * t.x + t.y * t.y) + (t.z * t.z + t.w * t.w); }
                    rstd8[ai * 4 + m] = ss; }
#pragma unroll
            for (int j = 0; j < 8; ++j) rstd8[j] += __shfl_xor(rstd8[j], 16);
#pragma unroll
            for (int j = 0; j < 8; ++j) rstd8[j] += __shfl_xor(rstd8[j], 32);
#pragma unroll
            for (int j = 0; j < 8; ++j) rstd8[j] = rsqrtf(rstd8[j] * (1.f / 64.f) + EPS);
            asm volatile("" ::: "memory"); __builtin_amdgcn_sched_barrier(0);
#pragma unroll
            for (int ai = 0; ai < 2; ++ai)
#pragma unroll
                for (int m = 0; m < 4; ++m) {
                    const int row = 128 * ai + 64 * wr + 16 * m + fr;
                    f32x4 y[2][2];
#pragma unroll
                    for (int bj = 0; bj < 2; ++bj)
#pragma unroll
                        for (int n = 0; n < 2; ++n) y[bj][n] = acc[ai][bj][m][n];
                    const float rstd = rstd8[ai * 4 + m];
#pragma unroll
                    for (int bj = 0; bj < 2; ++bj)
#pragma unroll
                        for (int n = 0; n < 2; ++n) y[bj][n] = y[bj][n] * rstd * gv[bj][n];
                    if (!prompt) {
                        const int t = t0 + row, grow = t >> 6, gcol = t & 63;
#pragma unroll
                        for (int n = 0; n < 2; ++n) { const int pos = n == 0 ? grow : gcol;
                            const f32x4 cs = *(const f32x4*)(rope + pos * 16 + 4 * fq), sn = *(const f32x4*)(rope + 1024 + pos * 16 + 4 * fq);
                            const f32x4 x1 = y[0][n], x2 = y[1][n];
                            y[0][n] = x1 * cs - x2 * sn; y[1][n] = x2 * cs + x1 * sn; }
                    }
#pragma unroll
                    for (int bj = 0; bj < 2; ++bj) { u32x4 o; o.x = pk2(y[bj][0].x, y[bj][0].y); o.y = pk2(y[bj][0].z, y[bj][0].w); o.z = pk2(y[bj][1].x, y[bj][1].y); o.w = pk2(y[bj][1].z, y[bj][1].w);
                        *(u32x4*)(dst + (size_t)row * dstS + 64 * wc + 32 * bj + 8 * fq) = o; }
                    if (fo) {
#pragma unroll
                        for (int bj = 0; bj < 2; ++bj)
#pragma unroll
                            for (int n = 0; n < 2; ++n) *(f32x4*)(fo + (size_t)row * foS + 64 * wc + 32 * n + 16 * bj + 4 * fq) = y[bj][n]; }
                    asm volatile("" ::: "memory"); __builtin_amdgcn_sched_barrier(0);
                }
        } else if (pn < 12 || pn == 17) {
            bf16_t* dst; int dstS; float* fo = nullptr;
            if (pn < 12) { dst = VA + (size_t)kvrow0 * 1024 + (pn - 8) * 256; dstS = 1024; if (prompt) fo = o_dv + m0 * 1024 + (pn - 8) * 256; }
            else { dst = VB + (size_t)kvrow0 * 256; dstS = 256; if (prompt) fo = o_wv + m0 * 256; }
#pragma unroll
            for (int ai = 0; ai < 2; ++ai)
#pragma unroll
                for (int m = 0; m < 4; ++m) { const int row = 128 * ai + 64 * wr + 16 * m + fr;
#pragma unroll
                    for (int bj = 0; bj < 2; ++bj) { const int col = 128 * bj + 32 * wc + 8 * fq; const f32x4 v0 = acc[ai][bj][m][0], v1 = acc[ai][bj][m][1];
                        u32x4 o; o.x = pk2(v0.x, v0.y); o.y = pk2(v0.z, v0.w); o.z = pk2(v1.x, v1.y); o.w = pk2(v1.z, v1.w);
                        *(u32x4*)(dst + (size_t)row * dstS + col) = o;
                        if (fo) { *(f32x4*)(fo + (size_t)row * dstS + col) = v0; *(f32x4*)(fo + (size_t)row * dstS + col + 4) = v1; } } }
        } else {
            bf16_t* dst = G + m0 * 2048 + (pn - 18) * 256;
#pragma unroll
            for (int ai = 0; ai < 2; ++ai)
#pragma unroll
                for (int m = 0; m < 4; ++m) { const int row = 128 * ai + 64 * wr + 16 * m + fr;
#pragma unroll
                    for (int bj = 0; bj < 2; ++bj) { const int col = 128 * bj + 32 * wc + 8 * fq; const f32x4 v0 = acc[ai][bj][m][0], v1 = acc[ai][bj][m][1];
                        u32x4 o; o.x = pk2(sigmoidf_(v0.x), sigmoidf_(v0.y)); o.y = pk2(sigmoidf_(v0.z), sigmoidf_(v0.w)); o.z = pk2(sigmoidf_(v1.x), sigmoidf_(v1.y)); o.w = pk2(sigmoidf_(v1.z), sigmoidf_(v1.w));
                        *(u32x4*)(dst + (size_t)row * 2048 + col) = o; } }
        }
    }
};
template <int MODE> struct EpiC8 {
    static constexpr bool PERM = true, AFTER_DRAIN = false;
    const bf16_t* G; float* T1; bf16_t* OB; const float* xp; const float* xs; const float* mod; float* X1;
    DI void operator()(const f32x4 (&acc)[2][2][4][2], const Unit& u, int wr, int wc, int fr, int fq) const {
        asm volatile("" : "+v"(fr), "+v"(fq));
        const int pn = u.pn, pm = u.pm; const size_t m0 = (size_t)pm * 256;
        const float* md = mod + (pm < 32 ? 0 : 1 + ((pm - 32) >> 3)) * 6144;
#pragma unroll
        for (int ai = 0; ai < 2; ++ai)
#pragma unroll
            for (int m = 0; m < 4; ++m) { const size_t row = m0 + 128 * ai + 64 * wr + 16 * m + fr;
                if (MODE == 4) { const int col = 128 * pn + 32 * wc + 8 * fq;
                    const f32x4 g0 = acc[ai][0][m][0], g1 = acc[ai][0][m][1], u0 = acc[ai][1][m][0], u1 = acc[ai][1][m][1];
                    u32x4 o; o.x = pk2(g0.x * sigmoidf_(g0.x) * u0.x, g0.y * sigmoidf_(g0.y) * u0.y); o.y = pk2(g0.z * sigmoidf_(g0.z) * u0.z, g0.w * sigmoidf_(g0.w) * u0.w);
                    o.z = pk2(g1.x * sigmoidf_(g1.x) * u1.x, g1.y * sigmoidf_(g1.y) * u1.y); o.w = pk2(g1.z * sigmoidf_(g1.z) * u1.z, g1.w * sigmoidf_(g1.w) * u1.w);
                    *(u32x4*)(OB + row * FF + col) = o;
                } else {
#pragma unroll
                    for (int bj = 0; bj < 2; ++bj) { const int col = 256 * pn + 128 * bj + 32 * wc + 8 * fq; const f32x4 v0 = acc[ai][bj][m][0], v1 = acc[ai][bj][m][1];
                        if (MODE == 0 || MODE == 1) {
                            const u32x4 gq = *(const u32x4*)(G + row * 2048 + (MODE == 1 ? 1024 : 0) + col);
                            const f32x4 ga = {bflo(gq.x), bfhi(gq.x), bflo(gq.y), bfhi(gq.y)}, gb = {bflo(gq.z), bfhi(gq.z), bflo(gq.w), bfhi(gq.w)};
                            bf16_t* T1b = (bf16_t*)T1;
                            if (MODE == 0) { const f32x4 t0 = ga * v0, t1 = gb * v1; u32x4 o; o.x = pk2(t0.x, t0.y); o.y = pk2(t0.z, t0.w); o.z = pk2(t1.x, t1.y); o.w = pk2(t1.z, t1.w); *(u32x4*)(T1b + row * D + col) = o; }
                            else { const u32x4 tq = *(const u32x4*)(T1b + row * D + col);
                                const f32x4 r0 = (f32x4){bflo(tq.x), bfhi(tq.x), bflo(tq.y), bfhi(tq.y)} + ga * v0, r1 = (f32x4){bflo(tq.z), bfhi(tq.z), bflo(tq.w), bfhi(tq.w)} + gb * v1;
                                u32x4 o; o.x = pk2(r0.x, r0.y); o.y = pk2(r0.z, r0.w); o.z = pk2(r1.x, r1.y); o.w = pk2(r1.z, r1.w); *(u32x4*)(OB + row * D + col) = o; }
                        } else if (MODE == 2) {
                            const int c0 = 256 * pn + 128 * bj + 32 * wc + 4 * fq;
                            const float* xr = row < MP ? xp + row * D : xs + (row - MP) * D;
                            const f32x4 g0 = *(const f32x4*)(md + 2048 + c0), g1 = *(const f32x4*)(md + 2048 + c0 + 16);
                            *(f32x4*)(X1 + row * D + c0) = *(const f32x4*)(xr + c0) + g0 * v0; *(f32x4*)(X1 + row * D + c0 + 16) = *(const f32x4*)(xr + c0 + 16) + g1 * v1;
                        } else {
                            const int c0 = 256 * pn + 128 * bj + 32 * wc + 4 * fq;
                            const f32x4 g0 = *(const f32x4*)(md + 5120 + c0), g1 = *(const f32x4*)(md + 5120 + c0 + 16);
                            float* xo = X1 + row * D + c0;
                            const f32x4 a0 = *(const f32x4*)xo, a1 = *(const f32x4*)(xo + 16);
                            *(f32x4*)xo = a0 + g0 * v0; *(f32x4*)(xo + 16) = a1 + g1 * v1;
                        } } } }
    }
};

DI float max3_(float a, float b, float c) { float r; asm("v_max3_f32 %0, %1, %2, %3" : "=v"(r) : "v"(a), "v"(b), "v"(c)); return r; }
template <int MODE>
DI void attn_unit(LAS unsigned char* lds, const bf16_t* Qw, bf16_t* Ow, const bf16_t* Kt, const bf16_t* Vt, int ra0, int ra1, int rb0, int rb1,
                  int qpos0, bool band, float sink_l2, float lam, const float* subg, int tid, int wave) {
    constexpr int KW = MODE == 0 ? 128 : 64, DV = KW, KS = MODE == 0 ? 1024 : 256;
    constexpr int KRS = KW * 2 + 16, VRS = DV * 2 + 64, KBYTES = 64 * KRS, VBYTES = 64 * VRS, VOFF = 2 * KBYTES;
    constexpr int CH = KW / 8, NL = 64 * CH / 512, NDV = DV / 32;
    constexpr float THR = 8.f;
    const int lane = tid & 63, h = lane >> 5, r = lane & 31;
    const int kc = MODE == 0 ? 64 * (wave >> 2) : 0;
    const int grp = wave >> 2;
    bf16x8 qf[4];
#pragma unroll
    for (int s = 0; s < 4; ++s) qf[s] = *(const bf16x8*)(Qw + (size_t)r * 1024 + 16 * s + 8 * h);
    f32x16 o[NDV], zero16, negm;
#pragma unroll
    for (int i = 0; i < 16; ++i) { zero16[i] = 0.f; negm[i] = 0.f; }
#pragma unroll
    for (int d = 0; d < NDV; ++d) o[d] = zero16;
    float mref = 0.f, lrun = 0.f; bool started = false, pact = false;
    bf16x8 pf[2][2];
#pragma unroll
    for (int a = 0; a < 2; ++a)
#pragma unroll
        for (int b = 0; b < 2; ++b) pf[a][b] = (bf16x8){0, 0, 0, 0, 0, 0, 0, 0};
    const int na = ra1 - ra0, nt = na + (rb1 - rb0);
    u32x4 kreg[NL], vreg[NL];
    const int q4 = (lane & 15) >> 2, p4 = lane & 3, blk = (lane >> 4) & 1;
    const unsigned goff = (unsigned)((tid / CH) * KS + (tid % CH) * 8) * 2u;
    const unsigned lks = (unsigned)((tid / CH) * KRS + (tid % CH) * 16), lvs = (unsigned)((tid / CH) * VRS + (tid % CH) * 16);
#define AT_KEY0(it) ((((it) < na) ? (ra0 + (it)) : (rb0 + (it) - na)) * 64)
#define AT_ACTIVE(key0_) (!((MODE == 1) && band && (key0_) < 2048) || (((key0_) + 63 >= qpos0 - 128) && ((key0_) <= qpos0 + 159)))
#define AT_GLOAD(it) do { const int key0_ = AT_KEY0(it); const char* kb_ = (const char*)(Kt + (size_t)key0_ * KS); const char* vb_ = (const char*)(Vt + (size_t)key0_ * KS); \
        _Pragma("unroll") for (int i_ = 0; i_ < NL; ++i_) { kreg[i_] = *(const u32x4*)(kb_ + (size_t)i_ * (512 / CH) * KS * 2 + goff); vreg[i_] = *(const u32x4*)(vb_ + (size_t)i_ * (512 / CH) * KS * 2 + goff); } } while (0)
#define AT_LSTORE(kb, vb) do { _Pragma("unroll") for (int i_ = 0; i_ < NL; ++i_) { \
        *(LAS u32x4*)(lds + (kb) * KBYTES + i_ * (512 / CH) * KRS + lks) = kreg[i_]; *(LAS u32x4*)(lds + VOFF + (vb) * VBYTES + i_ * (512 / CH) * VRS + lvs) = vreg[i_]; } } while (0)
#define AT_VREADK(F, ks) do { _Pragma("unroll") for (int d_ = 0; d_ < NDV; ++d_) { const LAS unsigned char* a_ = vbase + (16 * (ks)) * VRS + 64 * d_; \
        const s16x4 lo_ = vtr(a_), hi_ = vtr(a_ + 8 * VRS); F[d_] = __builtin_shufflevector(lo_, hi_, 0, 1, 2, 3, 4, 5, 6, 7); } } while (0)
#define AT_PVK(F, ks) do { __builtin_amdgcn_s_setprio(1); _Pragma("unroll") for (int d_ = 0; d_ < NDV; ++d_) o[d_] = MFMA32(F[d_], pf[(ks) >> 1][(ks) & 1], o[d_]); __builtin_amdgcn_s_setprio(0); } while (0)
#define AT_Y(VS) do { if (pact) { \
        const LAS unsigned char* vbase = lds + VOFF + (VS) * VBYTES + (4 * h + q4) * VRS + 32 * blk + 8 * p4; \
        bf16x8 vfa[NDV], vfb[NDV]; \
        AT_VREADK(vfa, 0); AT_VREADK(vfb, 1); __builtin_amdgcn_sched_barrier(0); \
        AT_PVK(vfa, 0); __builtin_amdgcn_sched_barrier(0); \
        AT_VREADK(vfa, 2); __builtin_amdgcn_sched_barrier(0); \
        AT_PVK(vfb, 1); __builtin_amdgcn_sched_barrier(0); \
        AT_VREADK(vfb, 3); __builtin_amdgcn_sched_barrier(0); \
        AT_PVK(vfa, 2); __builtin_amdgcn_sched_barrier(0); \
        AT_PVK(vfb, 3); __builtin_amdgcn_sched_barrier(0); \
        } } while (0)
    AT_GLOAD(0); AT_LSTORE(0, 0);
    __syncthreads();
    int vcur = 0, vprev = 2;
    for (int it = 0; it <= nt; ++it) {
        { const int tn_ = it + 1 < nt ? it + 1 : nt - 1; AT_GLOAD(tn_); }
        if (grp == 1) AT_Y(vprev);
        if (it < nt) {
            const int key0 = AT_KEY0(it);
            pact = AT_ACTIVE(key0);
            if (pact) {
                const LAS unsigned char* kl_ = lds + (it & 1) * KBYTES + r * KRS + (kc + 8 * h) * 2;
                bf16x8 kf0[4], kf1[4];
#pragma unroll
                for (int sd = 0; sd < 4; ++sd) { kf0[sd] = *(const LAS bf16x8*)(kl_ + 32 * sd); kf1[sd] = *(const LAS bf16x8*)(kl_ + 32 * KRS + 32 * sd); }
                __builtin_amdgcn_sched_barrier(0);
                f32x16 C0 = negm, C1 = negm;
                __builtin_amdgcn_s_setprio(1);
#pragma unroll
                for (int sd = 0; sd < 4; ++sd) { C0 = MFMA32(kf0[sd], qf[sd], C0); C1 = MFMA32(kf1[sd], qf[sd], C1); }
                __builtin_amdgcn_s_setprio(0);
                __builtin_amdgcn_sched_barrier(0);
                if ((MODE == 1) && band && key0 < 2048) { const int dq = key0 + 4 * h - (qpos0 + r);
#pragma unroll
                    for (int i = 0; i < 16; ++i) { const int d0 = dq + (i & 3) + 8 * (i >> 2), d1 = d0 + 32;
                        if (d0 < -128 || d0 > 128) C0[i] = -1e30f;
                        if (d1 < -128 || d1 > 128) C1[i] = -1e30f; } }
                float mx = max3_(C0[0], C1[0], C0[1]);
#pragma unroll
                for (int i = 1; i < 15; ++i) mx = max3_(mx, C1[i], C0[i + 1]);
                mx = fmaxf(mx, C1[15]);
                mx = fmaxf(mx, __shfl_xor(mx, 32));
                if (!started || __any(mx > THR)) {
                    const float dd = started ? fmaxf(mx, 0.f) : fmaxf(mx, -1e4f);
                    mref += dd;
#pragma unroll
                    for (int i = 0; i < 16; ++i) { C0[i] -= dd; C1[i] -= dd; negm[i] -= dd; }
                    if (started) { const float alpha = __builtin_amdgcn_exp2f(-dd); lrun *= alpha;
#pragma unroll
                        for (int d = 0; d < NDV; ++d) o[d] = o[d] * alpha; }
                    started = true;
                }
                float sum = 0.f;
#pragma unroll
                for (int i = 0; i < 16; ++i) { C0[i] = __builtin_amdgcn_exp2f(C0[i]); C1[i] = __builtin_amdgcn_exp2f(C1[i]); sum += C0[i] + C1[i]; }
                lrun += sum;
#pragma unroll
                for (int s = 0; s < 2; ++s) { u32x4 a, b;
                    a.x = pk2(C0[8 * s + 0], C0[8 * s + 1]); a.y = pk2(C0[8 * s + 2], C0[8 * s + 3]); a.z = pk2(C0[8 * s + 4], C0[8 * s + 5]); a.w = pk2(C0[8 * s + 6], C0[8 * s + 7]);
                    b.x = pk2(C1[8 * s + 0], C1[8 * s + 1]); b.y = pk2(C1[8 * s + 2], C1[8 * s + 3]); b.z = pk2(C1[8 * s + 4], C1[8 * s + 5]); b.w = pk2(C1[8 * s + 6], C1[8 * s + 7]);
                    pf[0][s] = __builtin_bit_cast(bf16x8, a); pf[1][s] = __builtin_bit_cast(bf16x8, b); }
            }
            if (grp == 0) AT_Y(vcur);
        }
        { const int vn_ = vcur == 2 ? 0 : vcur + 1; AT_LSTORE((it + 1) & 1, vn_); vprev = vcur; vcur = vn_; }
        __syncthreads();
    }
#undef AT_KEY0
#undef AT_ACTIVE
#undef AT_GLOAD
#undef AT_LSTORE
#undef AT_VREADK
#undef AT_PVK
#undef AT_Y
    float ltot = lrun + __shfl_xor(lrun, 32);
    if (MODE == 1) ltot += __builtin_amdgcn_exp2f(sink_l2 - mref);
    const float inv = 1.f / ltot;
#pragma unroll
    for (int d = 0; d < NDV; ++d) o[d] = o[d] * inv;
    if (MODE == 1) {
#pragma unroll
        for (int d = 0; d < NDV; ++d)
#pragma unroll
            for (int g = 0; g < 4; ++g) { u32x2 w; w.x = pk2(o[d][4 * g], o[d][4 * g + 1]); w.y = pk2(o[d][4 * g + 2], o[d][4 * g + 3]);
                *(u32x2*)(Ow + (size_t)r * 1024 + 32 * d + 8 * g + 4 * h) = w; }
    } else {
        LAS float* ex = (LAS float*)lds;
        if (wave >= 4) {
#pragma unroll
            for (int d = 0; d < NDV; ++d)
#pragma unroll
                for (int i = 0; i < 16; ++i) ex[((wave - 4) * (NDV * 16) + d * 16 + i) * 64 + lane] = o[d][i];
        }
        __syncthreads();
        if (wave < 4) {
            float ss = 0.f;
#pragma unroll
            for (int d = 0; d < NDV; ++d)
#pragma unroll
                for (int i = 0; i < 16; ++i) { const float v = o[d][i] - lam * ex[(wave * (NDV * 16) + d * 16 + i) * 64 + lane]; o[d][i] = v; ss += v * v; }
            ss += __shfl_xor(ss, 32);
            const float rstd = rsqrtf(ss * (1.f / 128.f) + EPS) * 0.8f;
#pragma unroll
            for (int d = 0; d < NDV; ++d)
#pragma unroll
                for (int g = 0; g < 4; ++g) { const f32x4 gg = *(const f32x4*)(subg + 32 * d + 8 * g + 4 * h);
                    u32x2 w; w.x = pk2(o[d][4 * g] * rstd * gg.x, o[d][4 * g + 1] * rstd * gg.y); w.y = pk2(o[d][4 * g + 2] * rstd * gg.z, o[d][4 * g + 3] * rstd * gg.w);
                    *(u32x2*)(Ow + (size_t)r * 1024 + 32 * d + 8 * g + 4 * h) = w; }
        }
    }
}

#define XB_TMO      128
#define XB_XCNT(j)  (256  + 64 * (j))
#define XB_XSUB(j)  (1280 + 64 * (j))
#define XB_XGEN(j)  (2304 + 64 * (j))
#define XB_TOP      3328
#define XB_TOPGEN   3392
#define XCD_BAR_WORDS 3456
#define XB_SPIN_CAP (1u << 18)

__device__ __forceinline__ unsigned xb_ld(unsigned* p)              { return __hip_atomic_load(p, __ATOMIC_RELAXED, __HIP_MEMORY_SCOPE_AGENT); }
__device__ __forceinline__ unsigned xb_add(unsigned* p, unsigned v) { return __hip_atomic_fetch_add(p, v, __ATOMIC_RELAXED, __HIP_MEMORY_SCOPE_AGENT); }
__device__ __forceinline__ unsigned xb_xcc_id() { return (unsigned)__builtin_amdgcn_s_getreg((3 << 11) | 20) & 0xFu; }
#define XB_SPIN(cond, bar) do { unsigned _sp = 0; while (cond) { __builtin_amdgcn_s_sleep(1); \
    if ((++_sp & 255u) == 0u) { if (xb_ld(&(bar)[XB_TMO])) break; if (_sp > XB_SPIN_CAP) { atomicAdd(&(bar)[XB_TMO], 1u); break; } } } } while (0)

struct XcdBarrier {
    unsigned* bar; unsigned x;
    volatile LAS unsigned* st;
};

__device__ __forceinline__ XcdBarrier xcd_barrier_post(unsigned* bar, volatile LAS unsigned* st) {
    XcdBarrier b; b.bar = bar; b.x = xb_xcc_id(); b.st = st;
    if (threadIdx.x == 0) (void)xb_add(&bar[XB_XCNT(b.x)], 1u);
    return b;
}
__device__ __forceinline__ void xcd_barrier_complete(unsigned* bar, unsigned x, unsigned& nloc, unsigned& nx) {
    const unsigned G = gridDim.x * gridDim.y * gridDim.z;
    unsigned sum, cnt, mine, sp = 0u;
    for (;;) {
        sum = 0u; cnt = 0u; mine = 0u;
#pragma unroll
        for (unsigned j = 0; j < 16; ++j) { const unsigned c = xb_ld(&bar[XB_XCNT(j)]); sum += c; cnt += (c > 0u) ? 1u : 0u; mine = (j == x) ? c : mine; }
        if (sum == G) break;
        __builtin_amdgcn_s_sleep(1);
        if ((++sp & 255u) == 0u) { if (xb_ld(&bar[XB_TMO])) break; if (sp > XB_SPIN_CAP) { atomicAdd(&bar[XB_TMO], 1u); break; } }
    }
    nloc = mine > 0u ? mine : 1u; nx = cnt > 0u ? cnt : 1u;
}

__device__ __forceinline__ void xcd_barrier(const XcdBarrier& b) {
    asm volatile("s_waitcnt vmcnt(0)" ::: "memory");
    __syncthreads();
    if (threadIdx.x == 0) {
        unsigned* bar = b.bar;
        __builtin_amdgcn_s_waitcnt(0);
        unsigned nloc = b.st[0], nx = b.st[1];
        if (nloc == 0u) { xcd_barrier_complete(bar, b.x, nloc, nx); b.st[0] = nloc; b.st[1] = nx; }
        const unsigned old = xb_add(&bar[XB_XSUB(b.x)], 1u);
        const unsigned gen = old / nloc;
        if (old + 1u == (gen + 1u) * nloc) {
            __builtin_amdgcn_fence(__ATOMIC_RELEASE, "agent");
            asm volatile("s_waitcnt vmcnt(0)" ::: "memory");
            const unsigned og = xb_add(&bar[XB_TOP], 1u);
            const unsigned tg = og / nx;
            if (og + 1u == (tg + 1u) * nx) xb_add(&bar[XB_TOPGEN], 1u);
            else XB_SPIN(xb_ld(&bar[XB_TOPGEN]) == tg, bar);
            __builtin_amdgcn_fence(__ATOMIC_ACQUIRE, "agent");
            xb_add(&bar[XB_XGEN(b.x)], 1u);
            asm volatile("s_waitcnt vmcnt(0)" ::: "memory");
        } else {
            XB_SPIN(xb_ld(&bar[XB_XGEN(b.x)]) == gen, bar);
            __builtin_amdgcn_fence(__ATOMIC_ACQUIRE, "agent");
            asm volatile("s_waitcnt vmcnt(0)" ::: "memory");
        }
    }
    __syncthreads();
}

__global__ void __launch_bounds__(512, 2) fwd_kernel(Params p) {
    extern __shared__ __attribute__((aligned(16))) unsigned char lds_raw[];
    LAS unsigned char* lds = (LAS unsigned char*)lds_raw;
    cg::grid_group grid = cg::this_grid();
    const int tid = threadIdx.x, lane = tid & 63, wave = __builtin_amdgcn_readfirstlane(tid >> 6);
    const int G = gridDim.x, bx = blockIdx.x;
    const int gw = bx * 8 + wave, ngw = G * 8, gtid = bx * 512 + tid, nthr = G * 512;
    unsigned char* ws = p.ws;
    float* mod = (float*)(ws + WS_MOD); const float* rope = (const float*)(ws + WS_ROPE);
    bf16_t *WIN = (bf16_t*)(ws + WS_WIN), *WOA = (bf16_t*)(ws + WS_WOA), *WOB = (bf16_t*)(ws + WS_WOB), *WOUT = (bf16_t*)(ws + WS_WOUT), *WGU = (bf16_t*)(ws + WS_WGU), *WDN = (bf16_t*)(ws + WS_WDN);
    bf16_t *H = (bf16_t*)(ws + WS_H), *QA = (bf16_t*)(ws + WS_QA), *QB = (bf16_t*)(ws + WS_QB), *KA = (bf16_t*)(ws + WS_KA), *VA = (bf16_t*)(ws + WS_VA), *KB = (bf16_t*)(ws + WS_KB), *VB = (bf16_t*)(ws + WS_VB);
    float* T1 = (float*)(ws + WS_T1); bf16_t* ACT = (bf16_t*)(ws + WS_ACT);
    bf16_t* Gt = (bf16_t*)p.out;
    float* X1 = p.out;

    volatile LAS unsigned* bst = (volatile LAS unsigned*)(lds + 131072 + 64);
    if (tid < 2) bst[tid] = 0u;
    if (bx == 0) for (int i = tid; i < XCD_BAR_WORDS; i += 512) ((unsigned*)(ws + WS_BAR))[i] = 0u;
    grid.sync();
    const XcdBarrier xbar = xcd_barrier_post((unsigned*)(ws + WS_BAR), bst);
    for (int task = bx; task < 193; task += G) p0_mod_task(p, task, lds, tid);
    __syncthreads();
    {
        LAS float* scr = (LAS float*)(lds + wave * 16384);
        constexpr int I_IN = 16 * (NIN / 32), I_SQ = 16 * 32, I_FF = 16 * (FF / 32), I_DN = (FF / 64) * 32;
        constexpr int NITEMS = I_IN + 3 * I_SQ;
        for (int it0 = gw; it0 < NITEMS; it0 += ngw) {
            int it = it0;
            if (it < I_IN) { transpose_item(p.w_in, D, NIN, WIN, -1, scr, it, lane); continue; } it -= I_IN;
            if (it < I_SQ) { transpose_item(p.w_oa, D, D, WOA, 0, scr, it, lane); continue; } it -= I_SQ;
            if (it < I_SQ) { transpose_item(p.w_ob, D, D, WOB, 0, scr, it, lane); continue; } it -= I_SQ;
            transpose_item(p.w_out, D, D, WOUT, 5, scr, it, lane);
        }
        for (int b = 0; b < 4; ++b) {
            const size_t kvr = (size_t)(MP + b * 2560 + 2048);
            convert_span_perm(p.cdk + (size_t)b * 512 * 1024, KA + kvr * 1024, 512 * 1024 / 4, gtid, nthr);
            convert_span(p.cdv + (size_t)b * 512 * 1024, VA + kvr * 1024, 512 * 1024 / 4, gtid, nthr);
            convert_span_perm(p.cwk + (size_t)b * 512 * 256, KB + kvr * 256, 512 * 256 / 4, gtid, nthr);
            convert_span(p.cwv + (size_t)b * 512 * 256, VB + kvr * 256, 512 * 256 / 4, gtid, nthr);
        }
    }
    xcd_barrier(xbar);
    norm_rows(p.x_prompt, p.x_sample, p.norm1_g, mod, 0, 1024, H, gw, ngw, lane);
    xcd_barrier(xbar);
#ifndef SKIP_P2
    {
        pg8::Gemm g{H, WIN, M, NIN, D}; pg8::StaticOrder S; S.init(M, NIN, G, bx);
        EpiIn E{ws, p.out};
        pg8::gemm_phase<EpiIn, pg8::StaticOrder, true, true>(lds, g, S, E);
        const int nfull = (M / 256) * (NIN / 256) - (((M / 256) * (NIN / 256)) / G) * G;
        if (bx >= nfull) {
            __syncthreads();
            LAS float* scr = (LAS float*)(lds + wave * 16384);
            constexpr int I_FF = 16 * (FF / 32), I_DN = (FF / 64) * 32;
            const int nidle = G - nfull;
            for (int it0 = (bx - nfull) * 8 + wave; it0 < 2 * I_FF + I_DN; it0 += nidle * 8) {
                int it = it0;
                if (it < I_FF) { transpose_item(p.w_gate, D, FF, WGU, 2, scr, it, lane); continue; } it -= I_FF;
                if (it < I_FF) { transpose_item(p.w_up, D, FF, WGU, 3, scr, it, lane); continue; } it -= I_FF;
                transpose_item(p.w_down, FF, D, WDN, 5, scr, it, lane);
            }
        }
    }
#endif
    xcd_barrier(xbar);
#ifndef SKIP_P3
    {
        const float lam = *(const float*)(ws + WS_LAM);
        for (int u = bx; u < 2048; u += G) {
            const int kind = u >> 9, v = u & 511, rr = v >> 8, cc = v & 255, xcd = cc & 7, slot = cc >> 3;
            int tid = threadIdx.x; asm volatile("" : "+v"(tid));
            __syncthreads();
            if (kind == 0) {
                const int bh = rr * 16 + xcd * 2 + (slot >> 4), qblk = slot & 15, b = bh >> 3, hh = bh & 7;
                const size_t rows = (size_t)MP + b * 2048 + qblk * 128 + 32 * (wave & 3), kv0 = (size_t)MP + b * 2560;
                attn_unit<0>(lds, QA + rows * 1024 + hh * 128 + 64 * (wave >> 2), QA + rows * 1024 + hh * 128, KA + kv0 * 1024 + hh * 128, VA + kv0 * 1024 + hh * 128,
                             0, 40, 0, 0, 0, false, 0.f, lam, p.subln_g, tid, wave);
            } else if (kind == 1) {
                const int bg = rr * 8 + xcd, hin = slot >> 3, qblk = slot & 7, b = bg >> 2, g4 = bg & 3, hq = g4 * 4 + hin;
                const size_t rows = (size_t)MP + b * 2048 + qblk * 256 + 32 * wave, kv0 = (size_t)MP + b * 2560;
                const int lo = 4 * qblk - 2 < 0 ? 0 : 4 * qblk - 2, hi = 4 * qblk + 6 > 32 ? 32 : 4 * qblk + 6;
                attn_unit<1>(lds, QB + rows * 1024 + hq * 64, QB + rows * 1024 + hq * 64, KB + kv0 * 256 + g4 * 64, VB + kv0 * 256 + g4 * 64,
                             32, 40, lo, hi, qblk * 256 + 32 * wave, true, p.sink[hq] * LOG2E, lam, p.subln_g, tid, wave);
            } else if (kind == 2) {
                const int b = v >> 4, hh = (v >> 1) & 7, half = v & 1;
                const size_t rows = (size_t)b * 256 + half * 128 + 32 * (wave & 3), kv0 = (size_t)b * 256;
                attn_unit<0>(lds, QA + rows * 1024 + hh * 128 + 64 * (wave >> 2), QA + rows * 1024 + hh * 128, KA + kv0 * 1024 + hh * 128, VA + kv0 * 1024 + hh * 128,
                             0, 4, 0, 0, 0, false, 0.f, lam, p.subln_g, tid, wave);
            } else {
                const int b = v >> 4, hq = v & 15, g4 = hq >> 2;
                const size_t rows = (size_t)b * 256 + 32 * wave, kv0 = (size_t)b * 256;
                attn_unit<1>(lds, QB + rows * 1024 + hq * 64, QB + rows * 1024 + hq * 64, KB + kv0 * 256 + g4 * 64, VB + kv0 * 256 + g4 * 64,
                             0, 4, 0, 0, 0, false, p.sink[hq] * LOG2E, lam, p.subln_g, tid, wave);
            }
        }
    }
#endif
    xcd_barrier(xbar);
#ifndef SKIP_P4
    {
        pg8::StaticOrder S; S.init(M, D, G, bx);
        { pg8::Gemm g{QA, WOA, M, D, D}; EpiC8<0> E{Gt, T1, nullptr, nullptr, nullptr, mod, nullptr}; pg8::gemm_phase<EpiC8<0>, pg8::StaticOrder, true, true>(lds, g, S, E); }
        __syncthreads();
        { pg8::Gemm g{QB, WOB, M, D, D}; EpiC8<1> E{Gt, T1, H, nullptr, nullptr, mod, nullptr}; pg8::gemm_phase<EpiC8<1>, pg8::StaticOrder, true, true>(lds, g, S, E); }
    }
#endif
    xcd_barrier(xbar);
#ifndef SKIP_P5
    {
        pg8::Gemm g{H, WOUT, M, D, D}; pg8::StaticOrder S; S.init(M, D, G, bx);
        EpiC8<2> E{nullptr, nullptr, nullptr, p.x_prompt, p.x_sample, mod, X1};
        pg8::gemm_phase<EpiC8<2>, pg8::StaticOrder, true, true>(lds, g, S, E);
    }
#endif
    xcd_barrier(xbar);
    norm_rows(X1, X1 + (size_t)MP * D, p.norm2_g, mod, 3072, 4096, H, gw, ngw, lane);
    xcd_barrier(xbar);
#ifndef SKIP_P7
    {
        pg8::Gemm g{H, WGU, M, 2 * FF, D}; pg8::StaticOrder S; S.init(M, 2 * FF, G, bx);
        EpiC8<4> E{nullptr, nullptr, ACT, nullptr, nullptr, mod, nullptr};
        pg8::gemm_phase<EpiC8<4>, pg8::StaticOrder, true, true>(lds, g, S, E);
    }
#endif
    xcd_barrier(xbar);
#ifndef SKIP_P8
    {
        pg8::Gemm g{ACT, WDN, M, D, FF}; pg8::StaticOrder S; S.init(M, D, G, bx);
        EpiC8<3> E{nullptr, nullptr, nullptr, nullptr, nullptr, mod, X1};
        pg8::gemm_phase<EpiC8<3>, pg8::StaticOrder, true, true>(lds, g, S, E);
    }
#endif
}

extern "C" void kernel_launch(void* const* d_in, const int* in_sizes, int n_in, void* d_out, int out_size, void* d_ws, size_t ws_size, hipStream_t stream) {
    static int grid = 0;
    if (grid == 0) {
        if (n_in != 29 || ws_size < WS_END) { fprintf(stderr, "kernel_launch: unexpected n_in %d / ws %zu\n", n_in, ws_size); grid = -1; return; }
        int dev = 0, cus = 0, per_cu = 0;
        (void)hipGetDevice(&dev); (void)hipDeviceGetAttribute(&cus, hipDeviceAttributeMultiprocessorCount, dev);
        if (hipFuncSetAttribute((const void*)fwd_kernel, hipFuncAttributeMaxDynamicSharedMemorySize, LDS_BYTES) != hipSuccess) fprintf(stderr, "kernel_launch: hipFuncSetAttribute failed\n");
        if (hipOccupancyMaxActiveBlocksPerMultiprocessor(&per_cu, (const void*)fwd_kernel, 512, LDS_BYTES) != hipSuccess || per_cu < 1) { fprintf(stderr, "kernel_launch: occupancy query gave %d\n", per_cu); per_cu = 1; }
        (void)hipGetLastError();
        grid = cus > 0 ? cus : 256;
    }
    if (grid < 0) return;
    Params p{};
    const float** pp = (const float**)&p;
    for (int i = 0; i < 29; ++i) pp[i] = (const float*)d_in[i];
    p.out = (float*)d_out; p.ws = (unsigned char*)d_ws;
    void* args[] = {&p};
    hipError_t e = hipLaunchCooperativeKernel((const void*)fwd_kernel, dim3(grid), dim3(512), args, LDS_BYTES, stream);
    if (e != hipSuccess) fprintf(stderr, "cooperative launch failed: %s (grid %d)\n", hipGetErrorString(e), grid);
}
```

```cpp
#include <hip/hip_runtime.h>
#include <hip/hip_cooperative_groups.h>
#include <cstdio>
#include <cstdint>
namespace cg = cooperative_groups;
namespace pg8 {
#define PG8_LAS __attribute__((address_space(3)))
typedef unsigned short bf16_t;
typedef short bf16x8 __attribute__((ext_vector_type(8)));
typedef float f32x4 __attribute__((ext_vector_type(4)));
typedef unsigned u32x4 __attribute__((ext_vector_type(4)));
constexpr int BM = 256, BK = 64, HALF = 128, HTB = HALF * BK * 2  , STAGE_BYTES = 8 * HTB, NXCD = 8, WGM = 4;

__host__ __device__ __forceinline__ int lds_byte(int r, int c) { const int st = (r >> 4) * 2 + (c >> 5), rr = r & 15, cc = c & 31, ob = rr * 64 + cc * 2; return st * 1024 + (ob ^ (((ob >> 9) & 1) << 5)); }
__host__ __device__ __forceinline__ void stage_rc(int b, int& R, int& C) { const int st = b / 1024, sb = b % 1024, swz = sb ^ (((sb >> 9) & 1) << 5); R = (st >> 1) * 16 + swz / 64; C = (st & 1) * 32 + (swz % 64) / 2; }
__host__ __device__ __forceinline__ int perm32(int rho) { const int n = rho >> 4, i = rho & 15; return 8 * (i >> 2) + 4 * n + (i & 3); }

struct Unit { int pm, pn; };
struct Gemm { const bf16_t* A; const bf16_t* Bt; int M, N, K; };

struct StaticOrder {
    int nM, nN, nwg, G, c;
    __host__ __device__ void init(int M, int N, int G_, int c_) { nM = M / BM; nN = N / BM; nwg = nM * nN; G = G_; c = c_; }
    __host__ __device__ bool next(int i, Unit& u) const {
        const long L = (long)i * G + c; if (L >= nwg) return false;
        int wgid = (int)L; { const int q = nwg / NXCD, r = nwg % NXCD, xcd = wgid % NXCD, off = wgid / NXCD; wgid = (xcd < r ? xcd * (q + 1) : r * (q + 1) + (xcd - r) * q) + off; }
        const int nig = WGM * nN, gid = wgid / nig, fm = gid * WGM, gsz = (nM - fm) < WGM ? (nM - fm) : WGM;
        u.pm = fm + ((wgid % nig) % gsz); u.pn = (wgid % nig) / gsz; return true;
    }
    __device__ __forceinline__ void a_ready(const Unit&) const {}
    __device__ __forceinline__ void done(const Unit&) const {}
};

__device__ __forceinline__ unsigned cvt_pk_bf16(float lo, float hi) { unsigned r; asm volatile("v_cvt_pk_bf16_f32 %0, %1, %2" : "=v"(r) : "v"(lo), "v"(hi)); return r; }

template <class Epi, class Sched, bool ALIGN_EPI = false, bool SP2 = false>
__device__ __forceinline__ void gemm_phase(PG8_LAS unsigned char* lds, const Gemm g, const Sched& S, const Epi& E) {
    int tid = threadIdx.x; asm volatile("" : "+v"(tid));
    const int wid = __builtin_amdgcn_readfirstlane(tid >> 6), lane = tid & 63, wr = wid >> 2, wc = wid & 3, fr = lane & 15, fq = lane >> 4;
    const int K = g.K, nt = K / BK;
    unsigned voffA[2], voffB[2];
#pragma unroll
    for (int i = 0; i < 2; ++i) { int R, C; stage_rc(tid * 16 + i * 8192, R, C); const int Rb = Epi::PERM ? ((R & ~31) + perm32(R & 31)) : R;
        voffA[i] = (unsigned)(R * K + C) * 2u; voffB[i] = (unsigned)(Rb * K + C) * 2u; }
    const size_t kstep = (size_t)(BK * 2);
    const size_t hstep = (size_t)HALF * K * 2;
    const size_t tstep = 2 * hstep;
    const unsigned ldsw = (unsigned)wid * 1024u;
    const int aoff = lds_byte(wr * 64 + fr, fq * 8), boff = lds_byte(wc * 32 + fr, fq * 8);
#define PG8_SA(b, h) (((b) * 2 + (h)) * HTB)
#define PG8_SB(b, h) ((4 + (b) * 2 + (h)) * HTB)
#define PG8_STAGE(bufoff, gbase, voff) do { _Pragma("unroll") for (int _i = 0; _i < 2; ++_i) \
        __builtin_amdgcn_global_load_lds((const unsigned*)((const char*)(gbase) + (voff)[_i]), (PG8_LAS unsigned*)(lds + (bufoff) + ldsw + _i * 8192), 16, 0, 0); } while (0)
#define PG8_LDA(dst, b, h) do { _Pragma("unroll") for (int m = 0; m < 4; ++m) _Pragma("unroll") for (int k = 0; k < 2; ++k) dst[m][k] = *(const PG8_LAS bf16x8*)(lds + PG8_SA(b, h) + aoff + m * 2048 + k * 1024); } while (0)
#define PG8_LDB(dst, b, h) do { _Pragma("unroll") for (int n = 0; n < 2; ++n) _Pragma("unroll") for (int k = 0; k < 2; ++k) dst[n][k] = *(const PG8_LAS bf16x8*)(lds + PG8_SB(b, h) + boff + n * 2048 + k * 1024); } while (0)
#define PG8_MMA(ai, bj, At, Bt) do { __builtin_amdgcn_s_setprio(1); _Pragma("unroll") for (int m = 0; m < 4; ++m) _Pragma("unroll") for (int n = 0; n < 2; ++n) _Pragma("unroll") for (int k = 0; k < 2; ++k) \
        acc[ai][bj][m][n] = __builtin_amdgcn_mfma_f32_16x16x32_bf16(Bt[n][k], At[m][k], acc[ai][bj][m][n], 0, 0, 0); __builtin_amdgcn_s_setprio(0); } while (0)
#define PG8_WAIT_V(n) asm volatile("s_waitcnt vmcnt(" #n ")" ::: "memory")
#define PG8_WAIT_L(n) asm volatile("s_waitcnt lgkmcnt(" #n ")" ::: "memory")
#define PG8_BAR __builtin_amdgcn_s_barrier()
#define PG8_SCHED __builtin_amdgcn_sched_barrier(0)
    Unit cur, nxt; int ui = 0;
    if (!S.next(0, cur)) return;
    f32x4 acc[2][2][4][2];
#pragma unroll
    for (int a = 0; a < 2; ++a)
#pragma unroll
        for (int b = 0; b < 2; ++b)
#pragma unroll
            for (int m = 0; m < 4; ++m)
#pragma unroll
                for (int n = 0; n < 2; ++n) acc[a][b][m][n] = (f32x4){0.f, 0.f, 0.f, 0.f};
    bf16x8 At[4][2], B0[2][2], B1[2][2];
    const char* cA = (const char*)g.A + (size_t)cur.pm * tstep; const char* cB = (const char*)g.Bt + (size_t)cur.pn * tstep;
    S.a_ready(cur);
    if constexpr (SP2) {
        PG8_STAGE(PG8_SB(0, 0), cB, voffB); PG8_STAGE(PG8_SB(0, 1), cB + hstep, voffB); PG8_STAGE(PG8_SA(0, 0), cA, voffA); PG8_STAGE(PG8_SA(0, 1), cA + hstep, voffA);
        if (wr == 1) PG8_BAR;
        PG8_WAIT_V(2); PG8_BAR;
        PG8_STAGE(PG8_SB(1, 0), cB + kstep, voffB); PG8_STAGE(PG8_SA(1, 0), cA + kstep, voffA); PG8_STAGE(PG8_SB(1, 1), cB + hstep + kstep, voffB);
        PG8_WAIT_V(6); PG8_BAR;
    } else {
        PG8_STAGE(PG8_SB(0, 0), cB, voffB); PG8_STAGE(PG8_SA(0, 0), cA, voffA); PG8_STAGE(PG8_SB(0, 1), cB + hstep, voffB); PG8_STAGE(PG8_SA(0, 1), cA + hstep, voffA);
        if (wr == 1) PG8_BAR;
        PG8_WAIT_V(4); PG8_BAR;
        PG8_STAGE(PG8_SB(1, 0), cB + kstep, voffB); PG8_STAGE(PG8_SA(1, 0), cA + kstep, voffA); PG8_STAGE(PG8_SB(1, 1), cB + hstep + kstep, voffB);
        PG8_WAIT_V(6); PG8_BAR;
    }
    for (;;) {
        const bool has_next = S.next(ui + 1, nxt);
        const char* nA = has_next ? (const char*)g.A + (size_t)nxt.pm * tstep : cA; const char* nB = has_next ? (const char*)g.Bt + (size_t)nxt.pn * tstep : cB;
        for (int t = 0; t < nt; t += 2) {
            const bool last = (t == nt - 2);
            const char* a1 = cA + (size_t)(t + 1) * kstep;
            const char* a2 = last ? nA : cA + (size_t)(t + 2) * kstep; const char* b2 = last ? nB : cB + (size_t)(t + 2) * kstep;
            const char* a3 = a2 + kstep; const char* b3 = b2 + kstep;
            if (last && has_next) S.a_ready(nxt);
            if constexpr (SP2) {
            PG8_LDB(B0, 0, 0); PG8_LDB(B1, 0, 1); PG8_SCHED; PG8_LDA(At, 0, 0); PG8_STAGE(PG8_SA(1, 1), a1 + hstep, voffA);
            PG8_WAIT_V(8); PG8_WAIT_L(0); PG8_BAR; PG8_MMA(0, 0, At, B0); PG8_MMA(0, 1, At, B1); PG8_BAR; PG8_SCHED;
            PG8_LDA(At, 0, 1); PG8_STAGE(PG8_SB(0, 0), b2, voffB); PG8_STAGE(PG8_SB(0, 1), b2 + hstep, voffB); PG8_STAGE(PG8_SA(0, 0), a2, voffA);
            PG8_WAIT_V(8); PG8_WAIT_L(0); PG8_BAR; PG8_MMA(1, 0, At, B0); PG8_MMA(1, 1, At, B1); PG8_BAR; PG8_SCHED;
            PG8_LDB(B0, 1, 0); PG8_LDB(B1, 1, 1); PG8_SCHED; PG8_LDA(At, 1, 0); PG8_STAGE(PG8_SA(0, 1), a2 + hstep, voffA);
            PG8_WAIT_V(8); PG8_WAIT_L(0); PG8_BAR; PG8_MMA(0, 0, At, B0); PG8_MMA(0, 1, At, B1); PG8_BAR; PG8_SCHED;
            PG8_LDA(At, 1, 1); PG8_STAGE(PG8_SB(1, 0), b3, voffB); PG8_STAGE(PG8_SB(1, 1), b3 + hstep, voffB); PG8_STAGE(PG8_SA(1, 0), a3, voffA);
            PG8_WAIT_V(8); PG8_WAIT_L(0); PG8_BAR; PG8_MMA(1, 0, At, B0); PG8_MMA(1, 1, At, B1); PG8_BAR; PG8_SCHED;
            } else {
            PG8_LDB(B0, 0, 0); PG8_SCHED; PG8_LDA(At, 0, 0); PG8_STAGE(PG8_SA(1, 1), a1 + hstep, voffA);
            PG8_WAIT_L(8); PG8_BAR; PG8_WAIT_L(0); PG8_MMA(0, 0, At, B0); PG8_BAR; PG8_SCHED;
            PG8_LDB(B1, 0, 1); PG8_STAGE(PG8_SB(0, 0), b2, voffB);
            PG8_BAR; PG8_WAIT_L(0); PG8_MMA(0, 1, At, B1); PG8_BAR;
            PG8_LDA(At, 0, 1); PG8_STAGE(PG8_SA(0, 0), a2, voffA);
            PG8_BAR; PG8_WAIT_L(0); PG8_MMA(1, 0, At, B0); PG8_BAR; PG8_SCHED;
            PG8_STAGE(PG8_SB(0, 1), b2 + hstep, voffB);
            PG8_WAIT_V(6); PG8_BAR; PG8_MMA(1, 1, At, B1); PG8_BAR;
            PG8_LDB(B0, 1, 0); PG8_SCHED; PG8_LDA(At, 1, 0); PG8_STAGE(PG8_SA(0, 1), a2 + hstep, voffA);
            PG8_WAIT_L(8); PG8_BAR; PG8_WAIT_L(0); PG8_MMA(0, 0, At, B0); PG8_BAR; PG8_SCHED;
            PG8_LDB(B1, 1, 1); PG8_STAGE(PG8_SB(1, 0), b3, voffB);
            PG8_BAR; PG8_WAIT_L(0); PG8_MMA(0, 1, At, B1); PG8_BAR;
            PG8_LDA(At, 1, 1); PG8_STAGE(PG8_SA(1, 0), a3, voffA);
            PG8_BAR; PG8_WAIT_L(0); PG8_MMA(1, 0, At, B0); PG8_BAR; PG8_SCHED;
            PG8_STAGE(PG8_SB(1, 1), b3 + hstep, voffB);
            PG8_WAIT_V(6); PG8_BAR; PG8_MMA(1, 1, At, B1); PG8_BAR;
            }
        }
        if constexpr (ALIGN_EPI) { if (wr == 0) PG8_BAR; }
        if constexpr (!Epi::AFTER_DRAIN) { E(acc, cur, wr, wc, fr, fq); S.done(cur); }
        if (!has_next) break;
#pragma unroll
        for (int a = 0; a < 2; ++a)
#pragma unroll
            for (int b = 0; b < 2; ++b)
#pragma unroll
                for (int m = 0; m < 4; ++m)
#pragma unroll
                    for (int n = 0; n < 2; ++n) acc[a][b][m][n] = (f32x4){0.f, 0.f, 0.f, 0.f};
        cur = nxt; cA = nA; cB = nB; ++ui;
        if constexpr (ALIGN_EPI) { if (wr == 1) PG8_BAR; }
    }
    PG8_WAIT_V(0);
    if constexpr (!ALIGN_EPI) { if (wr == 0) PG8_BAR; }
    PG8_BAR;
    if constexpr (Epi::AFTER_DRAIN) { E.fused(acc, cur, wr, wc, fr, fq, lds, wid, lane); S.done(cur); }
#undef PG8_SA
#undef PG8_SB
#undef PG8_STAGE
#undef PG8_LDA
#undef PG8_LDB
#undef PG8_MMA
#undef PG8_WAIT_V
#undef PG8_WAIT_L
#undef PG8_BAR
#undef PG8_SCHED
}
}

using pg8::bf16_t; using pg8::bf16x8; using pg8::f32x4; using pg8::u32x4; using pg8::Unit;
#define LAS __attribute__((address_space(3)))
typedef float f32x16 __attribute__((ext_vector_type(16)));
typedef short s16x4 __attribute__((ext_vector_type(4)));
typedef float f32x2_t __attribute__((ext_vector_type(2)));
typedef __bf16 bf16x2_t __attribute__((ext_vector_type(2)));
typedef unsigned u32x2 __attribute__((ext_vector_type(2)));
typedef short v4i16_t __attribute__((ext_vector_type(4)));

#define DI __device__ __forceinline__
DI unsigned pk2(float lo, float hi) { f32x2_t v = {lo, hi}; bf16x2_t b = __builtin_convertvector(v, bf16x2_t); return __builtin_bit_cast(unsigned, b); }
DI float bflo(unsigned u) { return __uint_as_float(u << 16); }
DI float bfhi(unsigned u) { return __uint_as_float(u & 0xffff0000u); }
DI float wave_sum(float v) {
#pragma unroll
    for (int o = 1; o < 64; o <<= 1) v += __shfl_xor(v, o);
    return v;
}
DI float sigmoidf_(float v) { return __builtin_amdgcn_rcpf(1.f + __builtin_amdgcn_exp2f(-1.4426950408889634f * v)); }
#define MFMA32(a, b, c) __builtin_amdgcn_mfma_f32_32x32x16_bf16((a), (b), (c), 0, 0, 0)
DI s16x4 vtr(const LAS unsigned char* p) { return __builtin_bit_cast(s16x4, __builtin_amdgcn_ds_read_tr16_b64_v4i16((LAS v4i16_t*)p)); }

constexpr int M = 16384, D = 1024, NIN = 6656, FF = 2816, MP = 8192;
constexpr float EPS = 1e-6f;
constexpr float C2 = 0.125f * 1.4426950408889634f;
constexpr float LOG2E = 1.4426950408889634f;
constexpr size_t MiB = 1u << 20;
constexpr size_t WS_MOD = 0, WS_ROPE = 128 * 1024, WS_LAM = 256 * 1024, WS_GAIN = 260 * 1024, WS_BAR = 512 * 1024;
constexpr size_t WS_WIN = 1 * MiB, WS_WOA = 14 * MiB, WS_WOB = 16 * MiB, WS_WOUT = 18 * MiB, WS_WGU = 20 * MiB, WS_WDN = 31 * MiB;
constexpr size_t WS_H = 37 * MiB, WS_QA = 69 * MiB, WS_QB = 101 * MiB, WS_KA = 133 * MiB, WS_VA = 169 * MiB, WS_KB = 205 * MiB, WS_VB = 214 * MiB;
constexpr size_t WS_T1 = WS_KA, WS_ACT = WS_KA, WS_END = 223 * MiB;
constexpr int LDS_BYTES = 147456;
constexpr size_t O_YS = 0, O_DK = 16777216, O_DV = 25165824, O_WK = 33554432, O_WV = 35651584;

struct Params {
    const float *x_prompt, *x_sample, *cdk, *cdv, *cwk, *cwv, *c, *c_ctx, *w_ada, *b_ada, *norm1_g, *w_in, *qn_a, *kn_a, *lq1, *lk1, *lq2, *lk2,
        *subln_g, *qn_b, *kn_b, *sink, *w_oa, *w_ob, *w_out, *norm2_g, *w_gate, *w_up, *w_down;
    float* out; unsigned char* ws;
};

DI void p0_mod_task(const Params& p, int task, LAS unsigned char* lds, int tid) {
    float* mod = (float*)(p.ws + WS_MOD);
    if (task < 192) {
        LAS float* s = (LAS float*)lds;
        LAS float* red = (LAS float*)(lds + 20480);
        for (int i = tid; i < 5 * 1024; i += 512) { const int r = i >> 10, k = i & 1023; const float v = r == 0 ? p.c_ctx[k] : p.c[(r - 1) * 1024 + k]; s[i] = v / (1.f + expf(-v)); }
        __syncthreads();
        const int ks = tid >> 5, col = tid & 31; const float* w = p.w_ada + task * 32 + col;
        float a0 = 0.f, a1 = 0.f, a2 = 0.f, a3 = 0.f, a4 = 0.f;
#pragma unroll 8
        for (int i = 0; i < 64; ++i) { const int k = ks + 16 * i; const float wv = w[(size_t)k * 6144];
            a0 += s[k] * wv; a1 += s[1024 + k] * wv; a2 += s[2048 + k] * wv; a3 += s[3072 + k] * wv; a4 += s[4096 + k] * wv; }
        red[(ks * 5 + 0) * 32 + col] = a0; red[(ks * 5 + 1) * 32 + col] = a1; red[(ks * 5 + 2) * 32 + col] = a2; red[(ks * 5 + 3) * 32 + col] = a3; red[(ks * 5 + 4) * 32 + col] = a4;
        __syncthreads();
        if (tid < 160) { const int r = tid >> 5, cc = tid & 31; float t = 0.f;
#pragma unroll
            for (int j = 0; j < 16; ++j) t += red[(j * 5 + r) * 32 + cc];
            mod[r * 6144 + task * 32 + cc] = t + p.b_ada[task * 32 + cc]; }
        __syncthreads();
    } else {
        float* tab = (float*)(p.ws + WS_ROPE);
        for (int i = tid; i < 1024; i += 512) { const int pos = i >> 4, j = i & 15; const float freq = powf(10000.f, -(float)j / 16.f); const float ang = (float)pos * freq; tab[i] = cosf(ang); tab[1024 + i] = sinf(ang); }
        if (tid < 256) { const int ty = tid >> 6, j = tid & 63; float* gt = (float*)(p.ws + WS_GAIN);
            gt[tid] = ty == 0 ? p.qn_a[j] * C2 : ty == 1 ? p.kn_a[j] : ty == 2 ? p.qn_b[j] * C2 : p.kn_b[j]; }
        if (tid < 64) { float a = p.lq1[tid] * p.lk1[tid], b = p.lq2[tid] * p.lk2[tid]; a = wave_sum(a); b = wave_sum(b); if (tid == 0) *(float*)(p.ws + WS_LAM) = expf(a) - expf(b) + 0.2f; }
    }
}
DI int wrow_map(int mode, int n) {
    if (mode == 1) { const int L = n & 255; return (n & ~255) + 128 * ((L >> 4) & 1) + 32 * (L >> 6) + 8 * ((L >> 2) & 3) + 4 * ((L >> 5) & 1) + (L & 3); }
    if (mode == 5) { const int L = n & 31; return (n & ~31) + 8 * ((L >> 2) & 3) + 4 * ((L >> 4) & 1) + (L & 3); }
    if (mode == 2) return 256 * (n >> 7) + (n & 127);
    if (mode == 3) return 256 * (n >> 7) + 128 + (n & 127);
    return n;
}
DI void transpose_item(const float* W, int K, int N, bf16_t* WT, int mode, LAS float* scr, int item, int lane) {
    const int nblk = N / 32, kb = item / nblk, nb = item % nblk, k0 = 64 * kb, n0 = 32 * nb;
    if (mode < 0) mode = (n0 < 2048 || (n0 >= 3072 && n0 < 4352)) ? 1 : 0;
#pragma unroll 8
    for (int i = 0; i < 32; ++i) { const int kk = 2 * i + (lane >> 5); scr[kk * 33 + (lane & 31)] = W[(size_t)(k0 + kk) * N + n0 + (lane & 31)]; }
    asm volatile("s_waitcnt lgkmcnt(0)" ::: "memory");
    const int c = lane & 7;
#pragma unroll
    for (int j = 0; j < 4; ++j) { const int n = (lane >> 3) + 8 * j; const LAS float* s = scr + (8 * c) * 33 + n;
        u32x4 o; o.x = pk2(s[0 * 33], s[1 * 33]); o.y = pk2(s[2 * 33], s[3 * 33]); o.z = pk2(s[4 * 33], s[5 * 33]); o.w = pk2(s[6 * 33], s[7 * 33]);
        *(u32x4*)(WT + (size_t)wrow_map(mode, n0 + n) * K + k0 + 8 * c) = o; }
    asm volatile("s_waitcnt lgkmcnt(0)" ::: "memory");
}
DI void convert_span(const float* src, bf16_t* dst, int n4, int gtid, int nthr) {
    for (int i = gtid; i < n4; i += nthr) { const f32x4 v = ((const f32x4*)src)[i]; u32x2 o; o.x = pk2(v.x, v.y); o.y = pk2(v.z, v.w); ((u32x2*)dst)[i] = o; }
}
DI void convert_span_perm(const float* src, bf16_t* dst, int n4, int gtid, int nthr) {
    for (int i = gtid; i < n4; i += nthr) { const f32x4 v = ((const f32x4*)src)[i]; u32x2 o; o.x = pk2(v.x, v.y); o.y = pk2(v.z, v.w);
        const int e0 = 4 * i, d0 = e0 & 63, pp = 32 * ((d0 >> 4) & 1) + 8 * ((d0 >> 2) & 3) + 4 * ((d0 >> 5) & 1);
        *(u32x2*)(dst + (e0 - d0) + pp) = o; }
}
DI void norm_rows(const float* xa, const float* xb, const float* gain, const float* mod, int sh_off, int sc_off, bf16_t* out, int gw, int ngw, int lane) {
    for (int m = gw; m < M; m += ngw) {
        const float* xr = m < MP ? xa + (size_t)m * D : xb + (size_t)(m - MP) * D;
        const float* md = mod + (m < MP ? 0 : 1 + ((m - MP) >> 11)) * 6144;
        f32x4 v[4]; float ss = 0.f;
#pragma unroll
        for (int j = 0; j < 4; ++j) { v[j] = *(const f32x4*)(xr + 4 * lane + 256 * j); ss += (v[j].x * v[j].x + v[j].y * v[j].y) + (v[j].z * v[j].z + v[j].w * v[j].w); }
        const float rstd = rsqrtf(wave_sum(ss) * (1.f / D) + EPS);
#pragma unroll
        for (int j = 0; j < 4; ++j) { const int col = 4 * lane + 256 * j;
            const f32x4 g = *(const f32x4*)(gain + col), sc = *(const f32x4*)(md + sc_off + col), sh = *(const f32x4*)(md + sh_off + col);
            const f32x4 y = v[j] * rstd * g * (sc + 1.0f) + sh;
            u32x2 o; o.x = pk2(y.x, y.y); o.y = pk2(y.z, y.w); *(u32x2*)(out + (size_t)m * D + col) = o; }
    }
}

struct EpiIn {
    static constexpr bool PERM = true, AFTER_DRAIN = false;
    unsigned char* ws; float* out;
    DI void operator()(const f32x4 (&acc)[2][2][4][2], const Unit& u, int wr, int wc, int fr, int fq) const {
        asm volatile("" : "+v"(fr), "+v"(fq));
        const int pn = u.pn, pm = u.pm; const bool prompt = pm < 32;
        bf16_t *QA = (bf16_t*)(ws + WS_QA), *KA = (bf16_t*)(ws + WS_KA), *VA = (bf16_t*)(ws + WS_VA), *QB = (bf16_t*)(ws + WS_QB), *KB = (bf16_t*)(ws + WS_KB), *VB = (bf16_t*)(ws + WS_VB), *G = (bf16_t*)out;
        float *o_dk = out + O_DK, *o_dv = out + O_DV, *o_wk = out + O_WK, *o_wv = out + O_WV;
        const float* rope = (const float*)(ws + WS_ROPE); const float* gains = (const float*)(ws + WS_GAIN);
        int kvrow0, t0;
        if (prompt) { kvrow0 = pm * 256; t0 = 0; } else { const int sm = pm - 32; t0 = (sm & 7) * 256; kvrow0 = MP + (sm >> 3) * 2560 + t0; }
        const size_t m0 = (size_t)pm * 256;
        if (pn < 8 || (pn >= 12 && pn < 17)) {
            const float* gain; bf16_t* dst; int dstS; float* fo = nullptr; int foS = 0;
            if (pn < 4) { gain = gains; dst = QA + m0 * 1024 + pn * 256; dstS = 1024; }
            else if (pn < 8) { gain = gains + 64; dst = KA + (size_t)kvrow0 * 1024 + (pn - 4) * 256; dstS = 1024; if (prompt) { fo = o_dk + m0 * 1024 + (pn - 4) * 256; foS = 1024; } }
            else if (pn < 16) { gain = gains + 128; dst = QB + m0 * 1024 + (pn - 12) * 256; dstS = 1024; }
            else { gain = gains + 192; dst = KB + (size_t)kvrow0 * 256; dstS = 256; if (prompt) { fo = o_wk + m0 * 256; foS = 256; } }
            f32x4 gv[2][2];
#pragma unroll
            for (int bj = 0; bj < 2; ++bj)
#pragma unroll
                for (int n = 0; n < 2; ++n) gv[bj][n] = *(const f32x4*)(gain + 32 * n + 16 * bj + 4 * fq);
            float rstd8[8];
#pragma unroll
            for (int ai = 0; ai < 2; ++ai)
#pragma unroll
                for (int m = 0; m < 4; ++m) { float ss = 0.f;
#pragma unroll
                    for (int bj = 0; bj < 2; ++bj)
#pragma unroll
                        for (int n = 0; n < 2; ++n) { const f32x4 t = acc[ai][bj][m][n]; ss += (t.x * t.x + t.y * t.y) + (t.z * t.z + t.w * t.w); }
                    rstd8[ai * 4 + m] = ss; }
#pragma unroll
            for (int j = 0; j < 8; ++j) rstd8[j] += __shfl_xor(rstd8[j], 16);
#pragma unroll
            for (int j = 0; j < 8; ++j) rstd8[j] += __shfl_xor(rstd8[j], 32);
#pragma unroll
            for (int j = 0; j < 8; ++j) rstd8[j] = rsqrtf(rstd8[j] * (1.f / 64.f) + EPS);
            asm volatile("" ::: "memory"); __builtin_amdgcn_sched_barrier(0);
#pragma unroll
            for (int ai = 0; ai < 2; ++ai)
#pragma unroll
                for (int m = 0; m < 4; ++m) {
                    const int row = 128 * ai + 64 * wr + 16 * m + fr;
                    f32x4 y[2][2];
#pragma unroll
                    for (int bj = 0; bj < 2; ++bj)
#pragma unroll
                        for (int n = 0; n < 2; ++n) y[bj][n] = acc[ai][bj][m][n];
                    const float rstd = rstd8[ai * 4 + m];
#pragma unroll
                    for (int bj = 0; bj < 2; ++bj)
#pragma unroll
                        for (int n = 0; n < 2; ++n) y[bj][n] = y[bj][n] * rstd * gv[bj][n];
                    if (!prompt) {
                        const int t = t0 + row, grow = t >> 6, gcol = t & 63;
#pragma unroll
                        for (int n = 0; n < 2; ++n) { const int pos = n == 0 ? grow : gcol;
                            const f32x4 cs = *(const f32x4*)(rope + pos * 16 + 4 * fq), sn = *(const f32x4*)(rope + 1024 + pos * 16 + 4 * fq);
                            const f32x4 x1 = y[0][n], x2 = y[1][n];
                            y[0][n] = x1 * cs - x2 * sn; y[1][n] = x2 * cs + x1 * sn; }
                    }
#pragma unroll
                    for (int bj = 0; bj < 2; ++bj) { u32x4 o; o.x = pk2(y[bj][0].x, y[bj][0].y); o.y = pk2(y[bj][0].z, y[bj][0].w); o.z = pk2(y[bj][1].x, y[bj][1].y); o.w = pk2(y[bj][1].z, y[bj][1].w);
                        *(u32x4*)(dst + (size_t)row * dstS + 64 * wc + 32 * bj + 8 * fq) = o; }
                    if (fo) {
#pragma unroll
                        for (int bj = 0; bj < 2; ++bj)
#pragma unroll
                            for (int n = 0; n < 2; ++n) *(f32x4*)(fo + (size_t)row * foS + 64 * wc + 32 * n + 16 * bj + 4 * fq) = y[bj][n]; }
                    asm volatile("" ::: "memory"); __builtin_amdgcn_sched_barrier(0);
                }
        } else if (pn < 12 || pn == 17) {
            bf16_t* dst; int dstS; float* fo = nullptr;
            if (pn < 12) { dst = VA + (size_t)kvrow0 * 1024 + (pn - 8) * 256; dstS = 1024; if (prompt) fo = o_dv + m0 * 1024 + (pn - 8) * 256; }
            else { dst = VB + (size_t)kvrow0 * 256; dstS = 256; if (prompt) fo = o_wv + m0 * 256; }
#pragma unroll
            for (int ai = 0; ai < 2; ++ai)
#pragma unroll
                for (int m = 0; m < 4; ++m) { const int row = 128 * ai + 64 * wr + 16 * m + fr;
#pragma unroll
                    for (int bj = 0; bj < 2; ++bj) { const int col = 128 * bj + 32 * wc + 8 * fq; const f32x4 v0 = acc[ai][bj][m][0], v1 = acc[ai][bj][m][1];
                        u32x4 o; o.x = pk2(v0.x, v0.y); o.y = pk2(v0.z, v0.w); o.z = pk2(v1.x, v1.y); o.w = pk2(v1.z, v1.w);
                        *(u32x4*)(dst + (size_t)row * dstS + col) = o;
                        if (fo) { *(f32x4*)(fo + (size_t)row * dstS + col) = v0; *(f32x4*)(fo + (size_t)row * dstS + col + 4) = v1; } } }
        } else {
            bf16_t* dst = G + m0 * 2048 + (pn - 18) * 256;
#pragma unroll
            for (int ai = 0; ai < 2; ++ai)
#pragma unroll
                for (int m = 0; m < 4; ++m) { const int row = 128 * ai + 64 * wr + 16 * m + fr;
#pragma unroll
                    for (int bj = 0; bj < 2; ++bj) { const int col = 128 * bj + 32 * wc + 8 * fq; const f32x4 v0 = acc[ai][bj][m][0], v1 = acc[ai][bj][m][1];
                        u32x4 o; o.x = pk2(sigmoidf_(v0.x), sigmoidf_(v0.y)); o.y = pk2(sigmoidf_(v0.z), sigmoidf_(v0.w)); o.z = pk2(sigmoidf_(v1.x), sigmoidf_(v1.y)); o.w = pk2(sigmoidf_(v1.z), sigmoidf_(v1.w));
                        *(u32x4*)(dst + (size_t)row * 2048 + col) = o; } }
        }
    }
};
template <int MODE> struct EpiC8 {
    static constexpr bool PERM = true, AFTER_DRAIN = false;
    const bf16_t* G; float* T1; bf16_t* OB; const float* xp; const float* xs; const float* mod; float* X1;
    DI void operator()(const f32x4 (&acc)[2][2][4][2], const Unit& u, int wr, int wc, int fr, int fq) const {
        asm volatile("" : "+v"(fr), "+v"(fq));
        const int pn = u.pn, pm = u.pm; const size_t m0 = (size_t)pm * 256;
        const float* md = mod + (pm < 32 ? 0 : 1 + ((pm - 32) >> 3)) * 6144;
#pragma unroll
        for (int ai = 0; ai < 2; ++ai)
#pragma unroll
            for (int m = 0; m < 4; ++m) { const size_t row = m0 + 128 * ai + 64 * wr + 16 * m + fr;
                if (MODE == 4) { const int col = 128 * pn + 32 * wc + 8 * fq;
                    const f32x4 g0 = acc[ai][0][m][0], g1 = acc[ai][0][m][1], u0 = acc[ai][1][m][0], u1 = acc[ai][1][m][1];
                    u32x4 o; o.x = pk2(g0.x * sigmoidf_(g0.x) * u0.x, g0.y * sigmoidf_(g0.y) * u0.y); o.y = pk2(g0.z * sigmoidf_(g0.z) * u0.z, g0.w * sigmoidf_(g0.w) * u0.w);
                    o.z = pk2(g1.x * sigmoidf_(g1.x) * u1.x, g1.y * sigmoidf_(g1.y) * u1.y); o.w = pk2(g1.z * sigmoidf_(g1.z) * u1.z, g1.w * sigmoidf_(g1.w) * u1.w);
                    *(u32x4*)(OB + row * FF + col) = o;
                } else {
#pragma unroll
                    for (int bj = 0; bj < 2; ++bj) { const int col = 256 * pn + 128 * bj + 32 * wc + 8 * fq; const f32x4 v0 = acc[ai][bj][m][0], v1 = acc[ai][bj][m][1];
                        if (MODE == 0 || MODE == 1) {
                            const u32x4 gq = *(const u32x4*)(G + row * 2048 + (MODE == 1 ? 1024 : 0) + col);
                            const f32x4 ga = {bflo(gq.x), bfhi(gq.x), bflo(gq.y), bfhi(gq.y)}, gb = {bflo(gq.z), bfhi(gq.z), bflo(gq.w), bfhi(gq.w)};
                            bf16_t* T1b = (bf16_t*)T1;
                            if (MODE == 0) { const f32x4 t0 = ga * v0, t1 = gb * v1; u32x4 o; o.x = pk2(t0.x, t0.y); o.y = pk2(t0.z, t0.w); o.z = pk2(t1.x, t1.y); o.w = pk2(t1.z, t1.w); *(u32x4*)(T1b + row * D + col) = o; }
                            else { const u32x4 tq = *(const u32x4*)(T1b + row * D + col);
                                const f32x4 r0 = (f32x4){bflo(tq.x), bfhi(tq.x), bflo(tq.y), bfhi(tq.y)} + ga * v0, r1 = (f32x4){bflo(tq.z), bfhi(tq.z), bflo(tq.w), bfhi(tq.w)} + gb * v1;
                                u32x4 o; o.x = pk2(r0.x, r0.y); o.y = pk2(r0.z, r0.w); o.z = pk2(r1.x, r1.y); o.w = pk2(r1.z, r1.w); *(u32x4*)(OB + row * D + col) = o; }
                        } else if (MODE == 2) {
                            const int c0 = 256 * pn + 128 * bj + 32 * wc + 4 * fq;
                            const float* xr = row < MP ? xp + row * D : xs + (row - MP) * D;
                            const f32x4 g0 = *(const f32x4*)(md + 2048 + c0), g1 = *(const f32x4*)(md + 2048 + c0 + 16);
                            *(f32x4*)(X1 + row * D + c0) = *(const f32x4*)(xr + c0) + g0 * v0; *(f32x4*)(X1 + row * D + c0 + 16) = *(const f32x4*)(xr + c0 + 16) + g1 * v1;
                        } else {
                            const int c0 = 256 * pn + 128 * bj + 32 * wc + 4 * fq;
                            const f32x4 g0 = *(const f32x4*)(md + 5120 + c0), g1 = *(const f32x4*)(md + 5120 + c0 + 16);
                            float* xo = X1 + row * D + c0;
                            const f32x4 a0 = *(const f32x4*)xo, a1 = *(const f32x4*)(xo + 16);
                            *(f32x4*)xo = a0 + g0 * v0; *(f32x4*)(xo + 16) = a1 + g1 * v1;
                        } } } }
    }
};

DI float max3_(float a, float b, float c) { float r; asm("v_max3_f32 %0, %1, %2, %3" : "=v"(r) : "v"(a), "v"(b), "v"(c)); return r; }
template <int MODE>
DI void attn_unit(LAS unsigned char* lds, const bf16_t* Qw, bf16_t* Ow, const bf16_t* Kt, const bf16_t* Vt, int ra0, int ra1, int rb0, int rb1,
                  int qpos0, bool band, float sink_l2, float lam, const float* subg, int tid, int wave) {
    constexpr int KW = MODE == 0 ? 128 : 64, DV = KW, KS = MODE == 0 ? 1024 : 256;
    constexpr int KRS = KW * 2 + 16, VRS = DV * 2 + 64, KBYTES = 64 * KRS, VBYTES = 64 * VRS, VOFF = 2 * KBYTES;
    constexpr int CH = KW / 8, NL = 64 * CH / 512, NDV = DV / 32;
    constexpr float THR = 8.f;
    const int lane = tid & 63, h = lane >> 5, r = lane & 31;
    const int kc = MODE == 0 ? 64 * (wave >> 2) : 0;
    const int grp = wave >> 2;
    bf16x8 qf[4];
#pragma unroll
    for (int s = 0; s < 4; ++s) qf[s] = *(const bf16x8*)(Qw + (size_t)r * 1024 + 16 * s + 8 * h);
    f32x16 o[NDV], zero16, negm;
#pragma unroll
    for (int i = 0; i < 16; ++i) { zero16[i] = 0.f; negm[i] = 0.f; }
#pragma unroll
    for (int d = 0; d < NDV; ++d) o[d] = zero16;
    float mref = 0.f, lrun = 0.f; bool started = false, pact = false;
    bf16x8 pf[2][2];
#pragma unroll
    for (int a = 0; a < 2; ++a)
#pragma unroll
        for (int b = 0; b < 2; ++b) pf[a][b] = (bf16x8){0, 0, 0, 0, 0, 0, 0, 0};
    const int na = ra1 - ra0, nt = na + (rb1 - rb0);
    u32x4 kreg[NL], vreg[NL];
    const int q4 = (lane & 15) >> 2, p4 = lane & 3, blk = (lane >> 4) & 1;
    const unsigned goff = (unsigned)((tid / CH) * KS + (tid % CH) * 8) * 2u;
    const unsigned lks = (unsigned)((tid / CH) * KRS + (tid % CH) * 16), lvs = (unsigned)((tid / CH) * VRS + (tid % CH) * 16);
#define AT_KEY0(it) ((((it) < na) ? (ra0 + (it)) : (rb0 + (it) - na)) * 64)
#define AT_ACTIVE(key0_) (!((MODE == 1) && band && (key0_) < 2048) || (((key0_) + 63 >= qpos0 - 128) && ((key0_) <= qpos0 + 159)))
#define AT_GLOAD(it) do { const int key0_ = AT_KEY0(it); const char* kb_ = (const char*)(Kt + (size_t)key0_ * KS); const char* vb_ = (const char*)(Vt + (size_t)key0_ * KS); \
        _Pragma("unroll") for (int i_ = 0; i_ < NL; ++i_) { kreg[i_] = *(const u32x4*)(kb_ + (size_t)i_ * (512 / CH) * KS * 2 + goff); vreg[i_] = *(const u32x4*)(vb_ + (size_t)i_ * (512 / CH) * KS * 2 + goff); } } while (0)
#define AT_LSTORE(kb, vb) do { _Pragma("unroll") for (int i_ = 0; i_ < NL; ++i_) { \
        *(LAS u32x4*)(lds + (kb) * KBYTES + i_ * (512 / CH) * KRS + lks) = kreg[i_]; *(LAS u32x4*)(lds + VOFF + (vb) * VBYTES + i_ * (512 / CH) * VRS + lvs) = vreg[i_]; } } while (0)
#define AT_VREADK(F, ks) do { _Pragma("unroll") for (int d_ = 0; d_ < NDV; ++d_) { const LAS unsigned char* a_ = vbase + (16 * (ks)) * VRS + 64 * d_; \
        const s16x4 lo_ = vtr(a_), hi_ = vtr(a_ + 8 * VRS); F[d_] = __builtin_shufflevector(lo_, hi_, 0, 1, 2, 3, 4, 5, 6, 7); } } while (0)
#define AT_PVK(F, ks) do { __builtin_amdgcn_s_setprio(1); _Pragma("unroll") for (int d_ = 0; d_ < NDV; ++d_) o[d_] = MFMA32(F[d_], pf[(ks) >> 1][(ks) & 1], o[d_]); __builtin_amdgcn_s_setprio(0); } while (0)
#define AT_Y(VS) do { if (pact) { \
        const LAS unsigned char* vbase = lds + VOFF + (VS) * VBYTES + (4 * h + q4) * VRS + 32 * blk + 8 * p4; \
        bf16x8 vfa[NDV], vfb[NDV]; \
        AT_VREADK(vfa, 0); AT_VREADK(vfb, 1); __builtin_amdgcn_sched_barrier(0); \
        AT_PVK(vfa, 0); __builtin_amdgcn_sched_barrier(0); \
        AT_VREADK(vfa, 2); __builtin_amdgcn_sched_barrier(0); \
        AT_PVK(vfb, 1); __builtin_amdgcn_sched_barrier(0); \
        AT_VREADK(vfb, 3); __builtin_amdgcn_sched_barrier(0); \
        AT_PVK(vfa, 2); __builtin_amdgcn_sched_barrier(0); \
        AT_PVK(vfb, 3); __builtin_amdgcn_sched_barrier(0); \
        } } while (0)
    AT_GLOAD(0); AT_LSTORE(0, 0);
    __syncthreads();
    int vcur = 0, vprev = 2;
    for (int it = 0; it <= nt; ++it) {
        { const int tn_ = it + 1 < nt ? it + 1 : nt - 1; AT_GLOAD(tn_); }
        if (grp == 1) AT_Y(vprev);
        if (it < nt) {
            const int key0 = AT_KEY0(it);
            pact = AT_ACTIVE(key0);
            if (pact) {
                const LAS unsigned char* kl_ = lds + (it & 1) * KBYTES + r * KRS + (kc + 8 * h) * 2;
                bf16x8 kf0[4], kf1[4];
#pragma unroll
                for (int sd = 0; sd < 4; ++sd) { kf0[sd] = *(const LAS bf16x8*)(kl_ + 32 * sd); kf1[sd] = *(const LAS bf16x8*)(kl_ + 32 * KRS + 32 * sd); }
                __builtin_amdgcn_sched_barrier(0);
                f32x16 C0 = negm, C1 = negm;
                __builtin_amdgcn_s_setprio(1);
#pragma unroll
                for (int sd = 0; sd < 4; ++sd) { C0 = MFMA32(kf0[sd], qf[sd], C0); C1 = MFMA32(kf1[sd], qf[sd], C1); }
                __builtin_amdgcn_s_setprio(0);
                __builtin_amdgcn_sched_barrier(0);
                if ((MODE == 1) && band && key0 < 2048) { const int dq = key0 + 4 * h - (qpos0 + r);
#pragma unroll
                    for (int i = 0; i < 16; ++i) { const int d0 = dq + (i & 3) + 8 * (i >> 2), d1 = d0 + 32;
                        if (d0 < -128 || d0 > 128) C0[i] = -1e30f;
                        if (d1 < -128 || d1 > 128) C1[i] = -1e30f; } }
                float mx = max3_(C0[0], C1[0], C0[1]);
#pragma unroll
                for (int i = 1; i < 15; ++i) mx = max3_(mx, C1[i], C0[i + 1]);
                mx = fmaxf(mx, C1[15]);
                mx = fmaxf(mx, __shfl_xor(mx, 32));
                if (!started || __any(mx > THR)) {
                    const float dd = started ? fmaxf(mx, 0.f) : fmaxf(mx, -1e4f);
                    mref += dd;
#pragma unroll
                    for (int i = 0; i < 16; ++i) { C0[i] -= dd; C1[i] -= dd; negm[i] -= dd; }
                    if (started) { const float alpha = __builtin_amdgcn_exp2f(-dd); lrun *= alpha;
#pragma unroll
                        for (int d = 0; d < NDV; ++d) o[d] = o[d] * alpha; }
                    started = true;
                }
                float sum = 0.f;
#pragma unroll
                for (int i = 0; i < 16; ++i) { C0[i] = __builtin_amdgcn_exp2f(C0[i]); C1[i] = __builtin_amdgcn_exp2f(C1[i]); sum += C0[i] + C1[i]; }
                lrun += sum;
#pragma unroll
                for (int s = 0; s < 2; ++s) { u32x4 a, b;
                    a.x = pk2(C0[8 * s + 0], C0[8 * s + 1]); a.y = pk2(C0[8 * s + 2], C0[8 * s + 3]); a.z = pk2(C0[8 * s + 4], C0[8 * s + 5]); a.w = pk2(C0[8 * s + 6], C0[8 * s + 7]);
                    b.x = pk2(C1[8 * s + 0], C1[8 * s + 1]); b.y = pk2(C1[8 * s + 2], C1[8 * s + 3]); b.z = pk2(C1[8 * s + 4], C1[8 * s + 5]); b.w = pk2(C1[8 * s + 6], C1[8 * s + 7]);
                    pf[0][s] = __builtin_bit_cast(bf16x8, a); pf[1][s] = __builtin_bit_cast(bf16x8, b); }
            }
            if (grp == 0) AT_Y(vcur);
        }
        { const int vn_ = vcur == 2 ? 0 : vcur + 1; AT_LSTORE((it + 1) & 1, vn_); vprev = vcur; vcur = vn_; }
        __syncthreads();
    }
#undef AT_KEY0
#undef AT_ACTIVE
#undef AT_GLOAD
#undef AT_LSTORE
#undef AT_VREADK
#undef AT_PVK
#undef AT_Y
    float ltot = lrun + __shfl_xor(lrun, 32);
    if (MODE == 1) ltot += __builtin_amdgcn_exp2f(sink_l2 - mref);
    const float inv = 1.f / ltot;
#pragma unroll
    for (int d = 0; d < NDV; ++d) o[d] = o[d] * inv;
    if (MODE == 1) {
#pragma unroll
        for (int d = 0; d < NDV; ++d)
#pragma unroll
            for (int g = 0; g < 4; ++g) { u32x2 w; w.x = pk2(o[d][4 * g], o[d][4 * g + 1]); w.y = pk2(o[d][4 * g + 2], o[d][4 * g + 3]);
                *(u32x2*)(Ow + (size_t)r * 1024 + 32 * d + 8 * g + 4 * h) = w; }
    } else {
        LAS float* ex = (LAS float*)lds;
        if (wave >= 4) {
#pragma unroll
            for (int d = 0; d < NDV; ++d)
#pragma unroll
                for (int i = 0; i < 16; ++i) ex[((wave - 4) * (NDV * 16) + d * 16 + i) * 64 + lane] = o[d][i];
        }
        __syncthreads();
        if (wave < 4) {
            float ss = 0.f;
#pragma unroll
            for (int d = 0; d < NDV; ++d)
#pragma unroll
                for (int i = 0; i < 16; ++i) { const float v = o[d][i] - lam * ex[(wave * (NDV * 16) + d * 16 + i) * 64 + lane]; o[d][i] = v; ss += v * v; }
            ss += __shfl_xor(ss, 32);
            const float rstd = rsqrtf(ss * (1.f / 128.f) + EPS) * 0.8f;
#pragma unroll
            for (int d = 0; d < NDV; ++d)
#pragma unroll
                for (int g = 0; g < 4; ++g) { const f32x4 gg = *(const f32x4*)(subg + 32 * d + 8 * g + 4 * h);
                    u32x2 w; w.x = pk2(o[d][4 * g] * rstd * gg.x, o[d][4 * g + 1] * rstd * gg.y); w.y = pk2(o[d][4 * g + 2] * rstd * gg.z, o[d][4 * g + 3] * rstd * gg.w);
                    *(u32x2*)(Ow + (size_t)r * 1024 + 32 * d + 8 * g + 4 * h) = w; }
        }
    }
}

#define XB_TMO      128
#define XB_XCNT(j)  (256  + 64 * (j))
#define XB_XSUB(j)  (1280 + 64 * (j))
#define XB_XGEN(j)  (2304 + 64 * (j))
#define XB_TOP      3328
#define XB_TOPGEN   3392
#define XCD_BAR_WORDS 3456
#define XB_SPIN_CAP (1u << 18)

__device__ __forceinline__ unsigned xb_ld(unsigned* p)              { return __hip_atomic_load(p, __ATOMIC_RELAXED, __HIP_MEMORY_SCOPE_AGENT); }
__device__ __forceinline__ unsigned xb_add(unsigned* p, unsigned v) { return __hip_atomic_fetch_add(p, v, __ATOMIC_RELAXED, __HIP_MEMORY_SCOPE_AGENT); }
__device__ __forceinline__ unsigned xb_xcc_id() { return (unsigned)__builtin_amdgcn_s_getreg((3 << 11) | 20) & 0xFu; }
#define XB_SPIN(cond, bar) do { unsigned _sp = 0; while (cond) { __builtin_amdgcn_s_sleep(1); \
    if ((++_sp & 255u) == 0u) { if (xb_ld(&(bar)[XB_TMO])) break; if (_sp > XB_SPIN_CAP) { atomicAdd(&(bar)[XB_TMO], 1u); break; } } } } while (0)

struct XcdBarrier {
    unsigned* bar; unsigned x;
    volatile LAS unsigned* st;
};

__device__ __forceinline__ XcdBarrier xcd_barrier_post(unsigned* bar, volatile LAS unsigned* st) {
    XcdBarrier b; b.bar = bar; b.x = xb_xcc_id(); b.st = st;
    if (threadIdx.x == 0) (void)xb_add(&bar[XB_XCNT(b.x)], 1u);
    return b;
}
__device__ __forceinline__ void xcd_barrier_complete(unsigned* bar, unsigned x, unsigned& nloc, unsigned& nx) {
    const unsigned G = gridDim.x * gridDim.y * gridDim.z;
    unsigned sum, cnt, mine, sp = 0u;
    for (;;) {
        sum = 0u; cnt = 0u; mine = 0u;
#pragma unroll
        for (unsigned j = 0; j < 16; ++j) { const unsigned c = xb_ld(&bar[XB_XCNT(j)]); sum += c; cnt += (c > 0u) ? 1u : 0u; mine = (j == x) ? c : mine; }
        if (sum == G) break;
        __builtin_amdgcn_s_sleep(1);
        if ((++sp & 255u) == 0u) { if (xb_ld(&bar[XB_TMO])) break; if (sp > XB_SPIN_CAP) { atomicAdd(&bar[XB_TMO], 1u); break; } }
    }
    nloc = mine > 0u ? mine : 1u; nx = cnt > 0u ? cnt : 1u;
}

__device__ __forceinline__ void xcd_barrier(const XcdBarrier& b) {
    asm volatile("s_waitcnt vmcnt(0)" ::: "memory");
    __syncthreads();
    if (threadIdx.x == 0) {
        unsigned* bar = b.bar;
        __builtin_amdgcn_s_waitcnt(0);
        unsigned nloc = b.st[0], nx = b.st[1];
        if (nloc == 0u) { xcd_barrier_complete(bar, b.x, nloc, nx); b.st[0] = nloc; b.st[1] = nx; }
        const unsigned old = xb_add(&bar[XB_XSUB(b.x)], 1u);
        const unsigned gen = old / nloc;
        if (old + 1u == (gen + 1u) * nloc) {
            __builtin_amdgcn_fence(__ATOMIC_RELEASE, "agent");
            asm volatile("s_waitcnt vmcnt(0)" ::: "memory");
            const unsigned og = xb_add(&bar[XB_TOP], 1u);
            const unsigned tg = og / nx;
            if (og + 1u == (tg + 1u) * nx) xb_add(&bar[XB_TOPGEN], 1u);
            else XB_SPIN(xb_ld(&bar[XB_TOPGEN]) == tg, bar);
            __builtin_amdgcn_fence(__ATOMIC_ACQUIRE, "agent");
            xb_add(&bar[XB_XGEN(b.x)], 1u);
            asm volatile("s_waitcnt vmcnt(0)" ::: "memory");
        } else {
            XB_SPIN(xb_ld(&bar[XB_XGEN(b.x)]) == gen, bar);
            __builtin_amdgcn_fence(__ATOMIC_ACQUIRE, "agent");
            asm volatile("s_waitcnt vmcnt(0)" ::: "memory");
        }
    }
    __syncthreads();
}

__global__ void __launch_bounds__(512, 2) fwd_kernel(Params p) {
    extern __shared__ __attribute__((aligned(16))) unsigned char lds_raw[];
    LAS unsigned char* lds = (LAS unsigned char*)lds_raw;
    cg::grid_group grid = cg::this_grid();
    const int tid = threadIdx.x, lane = tid & 63, wave = __builtin_amdgcn_readfirstlane(tid >> 6);
    const int G = gridDim.x, bx = blockIdx.x;
    const int gw = bx * 8 + wave, ngw = G * 8, gtid = bx * 512 + tid, nthr = G * 512;
    unsigned char* ws = p.ws;
    float* mod = (float*)(ws + WS_MOD); const float* rope = (const float*)(ws + WS_ROPE);
    bf16_t *WIN = (bf16_t*)(ws + WS_WIN), *WOA = (bf16_t*)(ws + WS_WOA), *WOB = (bf16_t*)(ws + WS_WOB), *WOUT = (bf16_t*)(ws + WS_WOUT), *WGU = (bf16_t*)(ws + WS_WGU), *WDN = (bf16_t*)(ws + WS_WDN);
    bf16_t *H = (bf16_t*)(ws + WS_H), *QA = (bf16_t*)(ws + WS_QA), *QB = (bf16_t*)(ws + WS_QB), *KA = (bf16_t*)(ws + WS_KA), *VA = (bf16_t*)(ws + WS_VA), *KB = (bf16_t*)(ws + WS_KB), *VB = (bf16_t*)(ws + WS_VB);
    float* T1 = (float*)(ws + WS_T1); bf16_t* ACT = (bf16_t*)(ws + WS_ACT);
    bf16_t* Gt = (bf16_t*)p.out;
    float* X1 = p.out;

    volatile LAS unsigned* bst = (volatile LAS unsigned*)(lds + 131072 + 64);
    if (tid < 2) bst[tid] = 0u;
    if (bx == 0) for (int i = tid; i < XCD_BAR_WORDS; i += 512) ((unsigned*)(ws + WS_BAR))[i] = 0u;
    grid.sync();
    const XcdBarrier xbar = xcd_barrier_post((unsigned*)(ws + WS_BAR), bst);
    for (int task = bx; task < 193; task += G) p0_mod_task(p, task, lds, tid);
    __syncthreads();
    {
        LAS float* scr = (LAS float*)(lds + wave * 16384);
        constexpr int I_IN = 16 * (NIN / 32), I_SQ = 16 * 32, I_FF = 16 * (FF / 32), I_DN = (FF / 64) * 32;
        constexpr int NITEMS = I_IN + 3 * I_SQ;
        for (int it0 = gw; it0 < NITEMS; it0 += ngw) {
            int it = it0;
            if (it < I_IN) { transpose_item(p.w_in, D, NIN, WIN, -1, scr, it, lane); continue; } it -= I_IN;
            if (it < I_SQ) { transpose_item(p.w_oa, D, D, WOA, 0, scr, it, lane); continue; } it -= I_SQ;
            if (it < I_SQ) { transpose_item(p.w_ob, D, D, WOB, 0, scr, it, lane); continue; } it -= I_SQ;
            transpose_item(p.w_out, D, D, WOUT, 5, scr, it, lane);
        }
        for (int b = 0; b < 4; ++b) {
            const size_t kvr = (size_t)(MP + b * 2560 + 2048);
            convert_span_perm(p.cdk + (size_t)b * 512 * 1024, KA + kvr * 1024, 512 * 1024 / 4, gtid, nthr);
            convert_span(p.cdv + (size_t)b * 512 * 1024, VA + kvr * 1024, 512 * 1024 / 4, gtid, nthr);
            convert_span_perm(p.cwk + (size_t)b * 512 * 256, KB + kvr * 256, 512 * 256 / 4, gtid, nthr);
            convert_span(p.cwv + (size_t)b * 512 * 256, VB + kvr * 256, 512 * 256 / 4, gtid, nthr);
        }
    }
    xcd_barrier(xbar);
    norm_rows(p.x_prompt, p.x_sample, p.norm1_g, mod, 0, 1024, H, gw, ngw, lane);
    xcd_barrier(xbar);
#ifndef SKIP_P2
    {
        pg8::Gemm g{H, WIN, M, NIN, D}; pg8::StaticOrder S; S.init(M, NIN, G, bx);
        EpiIn E{ws, p.out};
        pg8::gemm_phase<EpiIn, pg8::StaticOrder, true, true>(lds, g, S, E);
        const int nfull = (M / 256) * (NIN / 256) - (((M / 256) * (NIN / 256)) / G) * G;
        if (bx >= nfull) {
            __syncthreads();
            LAS float* scr = (LAS float*)(lds + wave * 16384);
            constexpr int I_FF = 16 * (FF / 32), I_DN = (FF / 64) * 32;
            const int nidle = G - nfull;
            for (int it0 = (bx - nfull) * 8 + wave; it0 < 2 * I_FF + I_DN; it0 += nidle * 8) {
                int it = it0;
                if (it < I_FF) { transpose_item(p.w_gate, D, FF, WGU, 2, scr, it, lane); continue; } it -= I_FF;
                if (it < I_FF) { transpose_item(p.w_up, D, FF, WGU, 3, scr, it, lane); continue; } it -= I_FF;
                transpose_item(p.w_down, FF, D, WDN, 5, scr, it, lane);
            }
        }
    }
#endif
    xcd_barrier(xbar);
#ifndef SKIP_P3
    {
        const float lam = *(const float*)(ws + WS_LAM);
        for (int u = bx; u < 2048; u += G) {
            const int kind = u >> 9, v = u & 511, rr = v >> 8, cc = v & 255, xcd = cc & 7, slot = cc >> 3;
            int tid = threadIdx.x; asm volatile("" : "+v"(tid));
            __syncthreads();
            if (kind == 0) {
                const int bh = rr * 16 + xcd * 2 + (slot >> 4), qblk = slot & 15, b = bh >> 3, hh = bh & 7;
                const size_t rows = (size_t)MP + b * 2048 + qblk * 128 + 32 * (wave & 3), kv0 = (size_t)MP + b * 2560;
                attn_unit<0>(lds, QA + rows * 1024 + hh * 128 + 64 * (wave >> 2), QA + rows * 1024 + hh * 128, KA + kv0 * 1024 + hh * 128, VA + kv0 * 1024 + hh * 128,
                             0, 40, 0, 0, 0, false, 0.f, lam, p.subln_g, tid, wave);
            } else if (kind == 1) {
                const int bg = rr * 8 + xcd, hin = slot >> 3, qblk = slot & 7, b = bg >> 2, g4 = bg & 3, hq = g4 * 4 + hin;
                const size_t rows = (size_t)MP + b * 2048 + qblk * 256 + 32 * wave, kv0 = (size_t)MP + b * 2560;
                const int lo = 4 * qblk - 2 < 0 ? 0 : 4 * qblk - 2, hi = 4 * qblk + 6 > 32 ? 32 : 4 * qblk + 6;
                attn_unit<1>(lds, QB + rows * 1024 + hq * 64, QB + rows * 1024 + hq * 64, KB + kv0 * 256 + g4 * 64, VB + kv0 * 256 + g4 * 64,
                             32, 40, lo, hi, qblk * 256 + 32 * wave, true, p.sink[hq] * LOG2E, lam, p.subln_g, tid, wave);
            } else if (kind == 2) {
                const int b = v >> 4, hh = (v >> 1) & 7, half = v & 1;
                const size_t rows = (size_t)b * 256 + half * 128 + 32 * (wave & 3), kv0 = (size_t)b * 256;
                attn_unit<0>(lds, QA + rows * 1024 + hh * 128 + 64 * (wave >> 2), QA + rows * 1024 + hh * 128, KA + kv0 * 1024 + hh * 128, VA + kv0 * 1024 + hh * 128,
                             0, 4, 0, 0, 0, false, 0.f, lam, p.subln_g, tid, wave);
            } else {
                const int b = v >> 4, hq = v & 15, g4 = hq >> 2;
                const size_t rows = (size_t)b * 256 + 32 * wave, kv0 = (size_t)b * 256;
                attn_unit<1>(lds, QB + rows * 1024 + hq * 64, QB + rows * 1024 + hq * 64, KB + kv0 * 256 + g4 * 64, VB + kv0 * 256 + g4 * 64,
                             0, 4, 0, 0, 0, false, p.sink[hq] * LOG2E, lam, p.subln_g, tid, wave);
            }
        }
    }
#endif
    xcd_barrier(xbar);
#ifndef SKIP_P4
    {
        pg8::StaticOrder S; S.init(M, D, G, bx);
        { pg8::Gemm g{QA, WOA, M, D, D}; EpiC8<0> E{Gt, T1, nullptr, nullptr, nullptr, mod, nullptr}; pg8::gemm_phase<EpiC8<0>, pg8::StaticOrder, true, true>(lds, g, S, E); }
        __syncthreads();
        { pg8::Gemm g{QB, WOB, M, D, D}; EpiC8<1> E{Gt, T1, H, nullptr, nullptr, mod, nullptr}; pg8::gemm_phase<EpiC8<1>, pg8::StaticOrder, true, true>(lds, g, S, E); }
    }
#endif
    xcd_barrier(xbar);
#ifndef SKIP_P5
    {
        pg8::Gemm g{H, WOUT, M, D, D}; pg8::StaticOrder S; S.init(M, D, G, bx);
        EpiC8<2> E{nullptr, nullptr, nullptr, p.x_prompt, p.x_sample, mod, X1};
        pg8::gemm_phase<EpiC8<2>, pg8::StaticOrder, true, true>(lds, g, S, E);
    }
#endif
    xcd_barrier(xbar);
    norm_rows(X1, X1 + (size_t)MP * D, p.norm2_g, mod, 3072, 4096, H, gw, ngw, lane);
    xcd_barrier(xbar);
#ifndef SKIP_P7
    {
        pg8::Gemm g{H, WGU, M, 2 * FF, D}; pg8::StaticOrder S; S.init(M, 2 * FF, G, bx);
        EpiC8<4> E{nullptr, nullptr, ACT, nullptr, nullptr, mod, nullptr};
        pg8::gemm_phase<EpiC8<4>, pg8::StaticOrder, true, true>(lds, g, S, E);
    }
#endif
    xcd_barrier(xbar);
#ifndef SKIP_P8
    {
        pg8::Gemm g{ACT, WDN, M, D, FF}; pg8::StaticOrder S; S.init(M, D, G, bx);
        EpiC8<3> E{nullptr, nullptr, nullptr, nullptr, nullptr, mod, X1};
        pg8::gemm_phase<EpiC8<3>, pg8::StaticOrder, true, true>(lds, g, S, E);
    }
#endif
}

extern "C" void kernel_launch(void* const* d_in, const int* in_sizes, int n_in, void* d_out, int out_size, void* d_ws, size_t ws_size, hipStream_t stream) {
    static int grid = 0;
    if (grid == 0) {
        if (n_in != 29 || ws_size < WS_END) { fprintf(stderr, "kernel_launch: unexpected n_in %d / ws %zu\n", n_in, ws_size); grid = -1; return; }
        int dev = 0, cus = 0, per_cu = 0;
        (void)hipGetDevice(&dev); (void)hipDeviceGetAttribute(&cus, hipDeviceAttributeMultiprocessorCount, dev);
        if (hipFuncSetAttribute((const void*)fwd_kernel, hipFuncAttributeMaxDynamicSharedMemorySize, LDS_BYTES) != hipSuccess) fprintf(stderr, "kernel_launch: hipFuncSetAttribute failed\n");
        if (hipOccupancyMaxActiveBlocksPerMultiprocessor(&per_cu, (const void*)fwd_kernel, 512, LDS_BYTES) != hipSuccess || per_cu < 1) { fprintf(stderr, "kernel_launch: occupancy query gave %d\n", per_cu); per_cu = 1; }
        (void)hipGetLastError();
        grid = cus > 0 ? cus : 256;
    }
    if (grid < 0) return;
    Params p{};
    const float** pp = (const float**)&p;
    for (int i = 0; i < 29; ++i) pp[i] = (const float*)d_in[i];
    p.out = (float*)d_out; p.ws = (unsigned char*)d_ws;
    void* args[] = {&p};
    hipError_t e = hipLaunchCooperativeKernel((const void*)fwd_kernel, dim3(grid), dim3(512), args, LDS_BYTES, stream);
    if (e != hipSuccess) fprintf(stderr, "cooperative launch failed: %s (grid %d)\n", hipGetErrorString(e), grid);
}
```

```cpp
#include <hip/hip_runtime.h>
#include <hip/hip_cooperative_groups.h>
#include <cstdio>
#include <cstdint>
namespace cg = cooperative_groups;
namespace pg8 {
#define PG8_LAS __attribute__((address_space(3)))
typedef unsigned short bf16_t;
typedef short bf16x8 __attribute__((ext_vector_type(8)));
typedef float f32x4 __attribute__((ext_vector_type(4)));
typedef unsigned u32x4 __attribute__((ext_vector_type(4)));
constexpr int BM = 256, BK = 64, HALF = 128, HTB = HALF * BK * 2  , STAGE_BYTES = 8 * HTB, NXCD = 8, WGM = 4;

__host__ __device__ __forceinline__ int lds_byte(int r, int c) { const int st = (r >> 4) * 2 + (c >> 5), rr = r & 15, cc = c & 31, ob = rr * 64 + cc * 2; return st * 1024 + (ob ^ (((ob >> 9) & 1) << 5)); }
__host__ __device__ __forceinline__ void stage_rc(int b, int& R, int& C) { const int st = b / 1024, sb = b % 1024, swz = sb ^ (((sb >> 9) & 1) << 5); R = (st >> 1) * 16 + swz / 64; C = (st & 1) * 32 + (swz % 64) / 2; }
__host__ __device__ __forceinline__ int perm32(int rho) { const int n = rho >> 4, i = rho & 15; return 8 * (i >> 2) + 4 * n + (i & 3); }

struct Unit { int pm, pn; };
struct Gemm { const bf16_t* A; const bf16_t* Bt; int M, N, K; };

struct StaticOrder {
    int nM, nN, nwg, G, c;
    __host__ __device__ void init(int M, int N, int G_, int c_) { nM = M / BM; nN = N / BM; nwg = nM * nN; G = G_; c = c_; }
    __host__ __device__ bool next(int i, Unit& u) const {
        const long L = (long)i * G + c; if (L >= nwg) return false;
        int wgid = (int)L; { const int q = nwg / NXCD, r = nwg % NXCD, xcd = wgid % NXCD, off = wgid / NXCD; wgid = (xcd < r ? xcd * (q + 1) : r * (q + 1) + (xcd - r) * q) + off; }
        const int nig = WGM * nN, gid = wgid / nig, fm = gid * WGM, gsz = (nM - fm) < WGM ? (nM - fm) : WGM;
        u.pm = fm + ((wgid % nig) % gsz); u.pn = (wgid % nig) / gsz; return true;
    }
    __device__ __forceinline__ void a_ready(const Unit&) const {}
    __device__ __forceinline__ void done(const Unit&) const {}
};

__device__ __forceinline__ unsigned cvt_pk_bf16(float lo, float hi) { unsigned r; asm volatile("v_cvt_pk_bf16_f32 %0, %1, %2" : "=v"(r) : "v"(lo), "v"(hi)); return r; }

template <class Epi, class Sched, bool ALIGN_EPI = false, bool SP2 = false>
__device__ __forceinline__ void gemm_phase(PG8_LAS unsigned char* lds, const Gemm g, const Sched& S, const Epi& E) {
    int tid = threadIdx.x; asm volatile("" : "+v"(tid));
    const int wid = __builtin_amdgcn_readfirstlane(tid >> 6), lane = tid & 63, wr = wid >> 2, wc = wid & 3, fr = lane & 15, fq = lane >> 4;
    const int K = g.K, nt = K / BK;
    unsigned voffA[2], voffB[2];
#pragma unroll
    for (int i = 0; i < 2; ++i) { int R, C; stage_rc(tid * 16 + i * 8192, R, C); const int Rb = Epi::PERM ? ((R & ~31) + perm32(R & 31)) : R;
        voffA[i] = (unsigned)(R * K + C) * 2u; voffB[i] = (unsigned)(Rb * K + C) * 2u; }
    const size_t kstep = (size_t)(BK * 2);
    const size_t hstep = (size_t)HALF * K * 2;
    const size_t tstep = 2 * hstep;
    const unsigned ldsw = (unsigned)wid * 1024u;
    const int aoff = lds_byte(wr * 64 + fr, fq * 8), boff = lds_byte(wc * 32 + fr, fq * 8);
#define PG8_SA(b, h) (((b) * 2 + (h)) * HTB)
#define PG8_SB(b, h) ((4 + (b) * 2 + (h)) * HTB)
#define PG8_STAGE(bufoff, gbase, voff) do { _Pragma("unroll") for (int _i = 0; _i < 2; ++_i) \
        __builtin_amdgcn_global_load_lds((const unsigned*)((const char*)(gbase) + (voff)[_i]), (PG8_LAS unsigned*)(lds + (bufoff) + ldsw + _i * 8192), 16, 0, 0); } while (0)
#define PG8_LDA(dst, b, h) do { _Pragma("unroll") for (int m = 0; m < 4; ++m) _Pragma("unroll") for (int k = 0; k < 2; ++k) dst[m][k] = *(const PG8_LAS bf16x8*)(lds + PG8_SA(b, h) + aoff + m * 2048 + k * 1024); } while (0)
#define PG8_LDB(dst, b, h) do { _Pragma("unroll") for (int n = 0; n < 2; ++n) _Pragma("unroll") for (int k = 0; k < 2; ++k) dst[n][k] = *(const PG8_LAS bf16x8*)(lds + PG8_SB(b, h) + boff + n * 2048 + k * 1024); } while (0)
#define PG8_MMA(ai, bj, At, Bt) do { __builtin_amdgcn_s_setprio(1); _Pragma("unroll") for (int m = 0; m < 4; ++m) _Pragma("unroll") for (int n = 0; n < 2; ++n) _Pragma("unroll") for (int k = 0; k < 2; ++k) \
        acc[ai][bj][m][n] = __builtin_amdgcn_mfma_f32_16x16x32_bf16(Bt[n][k], At[m][k], acc[ai][bj][m][n], 0, 0, 0); __builtin_amdgcn_s_setprio(0); } while (0)
#define PG8_WAIT_V(n) asm volatile("s_waitcnt vmcnt(" #n ")" ::: "memory")
#define PG8_WAIT_L(n) asm volatile("s_waitcnt lgkmcnt(" #n ")" ::: "memory")
#define PG8_BAR __builtin_amdgcn_s_barrier()
#define PG8_SCHED __builtin_amdgcn_sched_barrier(0)
    Unit cur, nxt; int ui = 0;
    if (!S.next(0, cur)) return;
    f32x4 acc[2][2][4][2];
#pragma unroll
    for (int a = 0; a < 2; ++a)
#pragma unroll
        for (int b = 0; b < 2; ++b)
#pragma unroll
            for (int m = 0; m < 4; ++m)
#pragma unroll
                for (int n = 0; n < 2; ++n) acc[a][b][m][n] = (f32x4){0.f, 0.f, 0.f, 0.f};
    bf16x8 At[4][2], B0[2][2], B1[2][2];
    const char* cA = (const char*)g.A + (size_t)cur.pm * tstep; const char* cB = (const char*)g.Bt + (size_t)cur.pn * tstep;
    S.a_ready(cur);
    if constexpr (SP2) {
        PG8_STAGE(PG8_SB(0, 0), cB, voffB); PG8_STAGE(PG8_SB(0, 1), cB + hstep, voffB); PG8_STAGE(PG8_SA(0, 0), cA, voffA); PG8_STAGE(PG8_SA(0, 1), cA + hstep, voffA);
        if (wr == 1) PG8_BAR;
        PG8_WAIT_V(2); PG8_BAR;
        PG8_STAGE(PG8_SB(1, 0), cB + kstep, voffB); PG8_STAGE(PG8_SA(1, 0), cA + kstep, voffA); PG8_STAGE(PG8_SB(1, 1), cB + hstep + kstep, voffB);
        PG8_WAIT_V(6); PG8_BAR;
    } else {
        PG8_STAGE(PG8_SB(0, 0), cB, voffB); PG8_STAGE(PG8_SA(0, 0), cA, voffA); PG8_STAGE(PG8_SB(0, 1), cB + hstep, voffB); PG8_STAGE(PG8_SA(0, 1), cA + hstep, voffA);
        if (wr == 1) PG8_BAR;
        PG8_WAIT_V(4); PG8_BAR;
        PG8_STAGE(PG8_SB(1, 0), cB + kstep, voffB); PG8_STAGE(PG8_SA(1, 0), cA + kstep, voffA); PG8_STAGE(PG8_SB(1, 1), cB + hstep + kstep, voffB);
        PG8_WAIT_V(6); PG8_BAR;
    }
    for (;;) {
        const bool has_next = S.next(ui + 1, nxt);
        const char* nA = has_next ? (const char*)g.A + (size_t)nxt.pm * tstep : cA; const char* nB = has_next ? (const char*)g.Bt + (size_t)nxt.pn * tstep : cB;
        for (int t = 0; t < nt; t += 2) {
            const bool last = (t == nt - 2);
            const char* a1 = cA + (size_t)(t + 1) * kstep;
            const char* a2 = last ? nA : cA + (size_t)(t + 2) * kstep; const char* b2 = last ? nB : cB + (size_t)(t + 2) * kstep;
            const char* a3 = a2 + kstep; const char* b3 = b2 + kstep;
            if (last && has_next) S.a_ready(nxt);
            if constexpr (SP2) {
            PG8_LDB(B0, 0, 0); PG8_LDB(B1, 0, 1); PG8_SCHED; PG8_LDA(At, 0, 0); PG8_STAGE(PG8_SA(1, 1), a1 + hstep, voffA);
            PG8_WAIT_V(8); PG8_WAIT_L(0); PG8_BAR; PG8_MMA(0, 0, At, B0); PG8_MMA(0, 1, At, B1); PG8_BAR; PG8_SCHED;
            PG8_LDA(At, 0, 1); PG8_STAGE(PG8_SB(0, 0), b2, voffB); PG8_STAGE(PG8_SB(0, 1), b2 + hstep, voffB); PG8_STAGE(PG8_SA(0, 0), a2, voffA);
            PG8_WAIT_V(8); PG8_WAIT_L(0); PG8_BAR; PG8_MMA(1, 0, At, B0); PG8_MMA(1, 1, At, B1); PG8_BAR; PG8_SCHED;
            PG8_LDB(B0, 1, 0); PG8_LDB(B1, 1, 1); PG8_SCHED; PG8_LDA(At, 1, 0); PG8_STAGE(PG8_SA(0, 1), a2 + hstep, voffA);
            PG8_WAIT_V(8); PG8_WAIT_L(0); PG8_BAR; PG8_MMA(0, 0, At, B0); PG8_MMA(0, 1, At, B1); PG8_BAR; PG8_SCHED;
            PG8_LDA(At, 1, 1); PG8_STAGE(PG8_SB(1, 0), b3, voffB); PG8_STAGE(PG8_SB(1, 1), b3 + hstep, voffB); PG8_STAGE(PG8_SA(1, 0), a3, voffA);
            PG8_WAIT_V(8); PG8_WAIT_L(0); PG8_BAR; PG8_MMA(1, 0, At, B0); PG8_MMA(1, 1, At, B1); PG8_BAR; PG8_SCHED;
            } else {
            PG8_LDB(B0, 0, 0); PG8_SCHED; PG8_LDA(At, 0, 0); PG8_STAGE(PG8_SA(1, 1), a1 + hstep, voffA);
            PG8_WAIT_L(8); PG8_BAR; PG8_WAIT_L(0); PG8_MMA(0, 0, At, B0); PG8_BAR; PG8_SCHED;
            PG8_LDB(B1, 0, 1); PG8_STAGE(PG8_SB(0, 0), b2, voffB);
            PG8_BAR; PG8_WAIT_L(0); PG8_MMA(0, 1, At, B1); PG8_BAR;
            PG8_LDA(At, 0, 1); PG8_STAGE(PG8_SA(0, 0), a2, voffA);
            PG8_BAR; PG8_WAIT_L(0); PG8_MMA(1, 0, At, B0); PG8_BAR; PG8_SCHED;
            PG8_STAGE(PG8_SB(0, 1), b2 + hstep, voffB);
            PG8_WAIT_V(6); PG8_BAR; PG8_MMA(1, 1, At, B1); PG8_BAR;
            PG8_LDB(B0, 1, 0); PG8_SCHED; PG8_LDA(At, 1, 0); PG8_STAGE(PG8_SA(0, 1), a2 + hstep, voffA);
            PG8_WAIT_L(8); PG8_BAR; PG8_WAIT_L(0); PG8_MMA(0, 0, At, B0); PG8_BAR; PG8_SCHED;
            PG8_LDB(B1, 1, 1); PG8_STAGE(PG8_SB(1, 0), b3, voffB);
            PG8_BAR; PG8_WAIT_L(0); PG8_MMA(0, 1, At, B1); PG8_BAR;
            PG8_LDA(At, 1, 1); PG8_STAGE(PG8_SA(1, 0), a3, voffA);
            PG8_BAR; PG8_WAIT_L(0); PG8_MMA(1, 0, At, B0); PG8_BAR; PG8_SCHED;
            PG8_STAGE(PG8_SB(1, 1), b3 + hstep, voffB);
            PG8_WAIT_V(6); PG8_BAR; PG8_MMA(1, 1, At, B1); PG8_BAR;
            }
        }
        if constexpr (ALIGN_EPI) { if (wr == 0) PG8_BAR; }
        if constexpr (!Epi::AFTER_DRAIN) { E(acc, cur, wr, wc, fr, fq); S.done(cur); }
        if (!has_next) break;
#pragma unroll
        for (int a = 0; a < 2; ++a)
#pragma unroll
            for (int b = 0; b < 2; ++b)
#pragma unroll
                for (int m = 0; m < 4; ++m)
#pragma unroll
                    for (int n = 0; n < 2; ++n) acc[a][b][m][n] = (f32x4){0.f, 0.f, 0.f, 0.f};
        cur = nxt; cA = nA; cB = nB; ++ui;
        if constexpr (ALIGN_EPI) { if (wr == 1) PG8_BAR; }
    }
    PG8_WAIT_V(0);
    if constexpr (!ALIGN_EPI) { if (wr == 0) PG8_BAR; }
    PG8_BAR;
    if constexpr (Epi::AFTER_DRAIN) { E.fused(acc, cur, wr, wc, fr, fq, lds, wid, lane); S.done(cur); }
#undef PG8_SA
#undef PG8_SB
#undef PG8_STAGE
#undef PG8_LDA
#undef PG8_LDB
#undef PG8_MMA
#undef PG8_WAIT_V
#undef PG8_WAIT_L
#undef PG8_BAR
#undef PG8_SCHED
}
}

using pg8::bf16_t; using pg8::bf16x8; using pg8::f32x4; using pg8::u32x4; using pg8::Unit;
#define LAS __attribute__((address_space(3)))
typedef float f32x16 __attribute__((ext_vector_type(16)));
typedef short s16x4 __attribute__((ext_vector_type(4)));
typedef float f32x2_t __attribute__((ext_vector_type(2)));
typedef __bf16 bf16x2_t __attribute__((ext_vector_type(2)));
typedef unsigned u32x2 __attribute__((ext_vector_type(2)));
typedef short v4i16_t __attribute__((ext_vector_type(4)));

#define DI __device__ __forceinline__
DI unsigned pk2(float lo, float hi) { f32x2_t v = {lo, hi}; bf16x2_t b = __builtin_convertvector(v, bf16x2_t); return __builtin_bit_cast(unsigned, b); }
DI float bflo(unsigned u) { return __uint_as_float(u << 16); }
DI float bfhi(unsigned u) { return __uint_as_float(u & 0xffff0000u); }
DI float wave_sum(float v) {
#pragma unroll
    for (int o = 1; o < 64; o <<= 1) v += __shfl_xor(v, o);
    return v;
}
DI float sigmoidf_(float v) { return __builtin_amdgcn_rcpf(1.f + __builtin_amdgcn_exp2f(-1.4426950408889634f * v)); }
#define MFMA32(a, b, c) __builtin_amdgcn_mfma_f32_32x32x16_bf16((a), (b), (c), 0, 0, 0)
DI s16x4 vtr(const LAS unsigned char* p) { return __builtin_bit_cast(s16x4, __builtin_amdgcn_ds_read_tr16_b64_v4i16((LAS v4i16_t*)p)); }

constexpr int M = 16384, D = 1024, NIN = 6656, FF = 2816, MP = 8192;
constexpr float EPS = 1e-6f;
constexpr float C2 = 0.125f * 1.4426950408889634f;
constexpr float LOG2E = 1.4426950408889634f;
constexpr size_t MiB = 1u << 20;
constexpr size_t WS_MOD = 0, WS_ROPE = 128 * 1024, WS_LAM = 256 * 1024, WS_GAIN = 260 * 1024, WS_BAR = 512 * 1024;
constexpr size_t WS_WIN = 1 * MiB, WS_WOA = 14 * MiB, WS_WOB = 16 * MiB, WS_WOUT = 18 * MiB, WS_WGU = 20 * MiB, WS_WDN = 31 * MiB;
constexpr size_t WS_H = 37 * MiB, WS_QA = 69 * MiB, WS_QB = 101 * MiB, WS_KA = 133 * MiB, WS_VA = 169 * MiB, WS_KB = 205 * MiB, WS_VB = 214 * MiB;
constexpr size_t WS_T1 = WS_KA, WS_ACT = WS_KA, WS_END = 223 * MiB;
constexpr int LDS_BYTES = 147456;
constexpr size_t O_YS = 0, O_DK = 16777216, O_DV = 25165824, O_WK = 33554432, O_WV = 35651584;

struct Params {
    const float *x_prompt, *x_sample, *cdk, *cdv, *cwk, *cwv, *c, *c_ctx, *w_ada, *b_ada, *norm1_g, *w_in, *qn_a, *kn_a, *lq1, *lk1, *lq2, *lk2,
        *subln_g, *qn_b, *kn_b, *sink, *w_oa, *w_ob, *w_out, *norm2_g, *w_gate, *w_up, *w_down;
    float* out; unsigned char* ws;
};

DI void p0_mod_task(const Params& p, int task, LAS unsigned char* lds, int tid) {
    float* mod = (float*)(p.ws + WS_MOD);
    if (task < 192) {
        LAS float* s = (LAS float*)lds;
        LAS float* red = (LAS float*)(lds + 20480);
        for (int i = tid; i < 5 * 1024; i += 512) { const int r = i >> 10, k = i & 1023; const float v = r == 0 ? p.c_ctx[k] : p.c[(r - 1) * 1024 + k]; s[i] = v / (1.f + expf(-v)); }
        __syncthreads();
        const int ks = tid >> 5, col = tid & 31; const float* w = p.w_ada + task * 32 + col;
        float a0 = 0.f, a1 = 0.f, a2 = 0.f, a3 = 0.f, a4 = 0.f;
#pragma unroll 8
        for (int i = 0; i < 64; ++i) { const int k = ks + 16 * i; const float wv = w[(size_t)k * 6144];
            a0 += s[k] * wv; a1 += s[1024 + k] * wv; a2 += s[2048 + k] * wv; a3 += s[3072 + k] * wv; a4 += s[4096 + k] * wv; }
        red[(ks * 5 + 0) * 32 + col] = a0; red[(ks * 5 + 1) * 32 + col] = a1; red[(ks * 5 + 2) * 32 + col] = a2; red[(ks * 5 + 3) * 32 + col] = a3; red[(ks * 5 + 4) * 32 + col] = a4;
        __syncthreads();
        if (tid < 160) { const int r = tid >> 5, cc = tid & 31; float t = 0.f;
#pragma unroll
            for (int j = 0; j < 16; ++j) t += red[(j * 5 + r) * 32 + cc];
            mod[r * 6144 + task * 32 + cc] = t + p.b_ada[task * 32 + cc]; }
        __syncthreads();
    } else {
        float* tab = (float*)(p.ws + WS_ROPE);
        for (int i = tid; i < 1024; i += 512) { const int pos = i >> 4, j = i & 15; const float freq = powf(10000.f, -(float)j / 16.f); const float ang = (float)pos * freq; tab[i] = cosf(ang); tab[1024 + i] = sinf(ang); }
        if (tid < 256) { const int ty = tid >> 6, j = tid & 63; float* gt = (float*)(p.ws + WS_GAIN);
            gt[tid] = ty == 0 ? p.qn_a[j] * C2 : ty == 1 ? p.kn_a[j] : ty == 2 ? p.qn_b[j] * C2 : p.kn_b[j]; }
        if (tid < 64) { float a = p.lq1[tid] * p.lk1[tid], b = p.lq2[tid] * p.lk2[tid]; a = wave_sum(a); b = wave_sum(b); if (tid == 0) *(float*)(p.ws + WS_LAM) = expf(a) - expf(b) + 0.2f; }
    }
}
DI int wrow_map(int mode, int n) {
    if (mode == 1) { const int L = n & 255; return (n & ~255) + 128 * ((L >> 4) & 1) + 32 * (L >> 6) + 8 * ((L >> 2) & 3) + 4 * ((L >> 5) & 1) + (L & 3); }
    if (mode == 5) { const int L = n & 31; return (n & ~31) + 8 * ((L >> 2) & 3) + 4 * ((L >> 4) & 1) + (L & 3); }
    if (mode == 2) return 256 * (n >> 7) + (n & 127);
    if (mode == 3) return 256 * (n >> 7) + 128 + (n & 127);
    return n;
}
DI void transpose_item(const float* W, int K, int N, bf16_t* WT, int mode, LAS float* scr, int item, int lane) {
    const int nblk = N / 32, kb = item / nblk, nb = item % nblk, k0 = 64 * kb, n0 = 32 * nb;
    if (mode < 0) mode = (n0 < 2048 || (n0 >= 3072 && n0 < 4352)) ? 1 : 0;
#pragma unroll 8
    for (int i = 0; i < 32; ++i) { const int kk = 2 * i + (lane >> 5); scr[kk * 33 + (lane & 31)] = W[(size_t)(k0 + kk) * N + n0 + (lane & 31)]; }
    asm volatile("s_waitcnt lgkmcnt(0)" ::: "memory");
    const int c = lane & 7;
#pragma unroll
    for (int j = 0; j < 4; ++j) { const int n = (lane >> 3) + 8 * j; const LAS float* s = scr + (8 * c) * 33 + n;
        u32x4 o; o.x = pk2(s[0 * 33], s[1 * 33]); o.y = pk2(s[2 * 33], s[3 * 33]); o.z = pk2(s[4 * 33], s[5 * 33]); o.w = pk2(s[6 * 33], s[7 * 33]);
        *(u32x4*)(WT + (size_t)wrow_map(mode, n0 + n) * K + k0 + 8 * c) = o; }
    asm volatile("s_waitcnt lgkmcnt(0)" ::: "memory");
}
DI void convert_span(const float* src, bf16_t* dst, int n4, int gtid, int nthr) {
    for (int i = gtid; i < n4; i += nthr) { const f32x4 v = ((const f32x4*)src)[i]; u32x2 o; o.x = pk2(v.x, v.y); o.y = pk2(v.z, v.w); ((u32x2*)dst)[i] = o; }
}
DI void convert_span_perm(const float* src, bf16_t* dst, int n4, int gtid, int nthr) {
    for (int i = gtid; i < n4; i += nthr) { const f32x4 v = ((const f32x4*)src)[i]; u32x2 o; o.x = pk2(v.x, v.y); o.y = pk2(v.z, v.w);
        const int e0 = 4 * i, d0 = e0 & 63, pp = 32 * ((d0 >> 4) & 1) + 8 * ((d0 >> 2) & 3) + 4 * ((d0 >> 5) & 1);
        *(u32x2*)(dst + (e0 - d0) + pp) = o; }
}
DI void norm_rows(const float* xa, const float* xb, const float* gain, const float* mod, int sh_off, int sc_off, bf16_t* out, int gw, int ngw, int lane) {
    for (int m = gw; m < M; m += ngw) {
        const float* xr = m < MP ? xa + (size_t)m * D : xb + (size_t)(m - MP) * D;
        const float* md = mod + (m < MP ? 0 : 1 + ((m - MP) >> 11)) * 6144;
        f32x4 v[4]; float ss = 0.f;
#pragma unroll
        for (int j = 0; j < 4; ++j) { v[j] = *(const f32x4*)(xr + 4 * lane + 256 * j); ss += (v[j].x * v[j].x + v[j].y * v[j].y) + (v[j].z * v[j].z + v[j].w * v[j].w); }
        const float rstd = rsqrtf(wave_sum(ss) * (1.f / D) + EPS);
#pragma unroll
        for (int j = 0; j < 4; ++j) { const int col = 4 * lane + 256 * j;
            const f32x4 g = *(const f32x4*)(gain + col), sc = *(const f32x4*)(md + sc_off + col), sh = *(const f32x4*)(md + sh_off + col);
            const f32x4 y = v[j] * rstd * g * (sc + 1.0f) + sh;
            u32x2 o; o.x = pk2(y.x, y.y); o.y = pk2(y.z, y.w); *(u32x2*)(out + (size_t)m * D + col) = o; }
    }
}

struct EpiIn {
    static constexpr bool PERM = true, AFTER_DRAIN = false;
    unsigned char* ws; float* out;
    DI void operator()(const f32x4 (&acc)[2][2][4][2], const Unit& u, int wr, int wc, int fr, int fq) const {
        asm volatile("" : "+v"(fr), "+v"(fq));
        const int pn = u.pn, pm = u.pm; const bool prompt = pm < 32;
        bf16_t *QA = (bf16_t*)(ws + WS_QA), *KA = (bf16_t*)(ws + WS_KA), *VA = (bf16_t*)(ws + WS_VA), *QB = (bf16_t*)(ws + WS_QB), *KB = (bf16_t*)(ws + WS_KB), *VB = (bf16_t*)(ws + WS_VB), *G = (bf16_t*)out;
        float *o_dk = out + O_DK, *o_dv = out + O_DV, *o_wk = out + O_WK, *o_wv = out + O_WV;
        const float* rope = (const float*)(ws + WS_ROPE); const float* gains = (const float*)(ws + WS_GAIN);
        int kvrow0, t0;
        if (prompt) { kvrow0 = pm * 256; t0 = 0; } else { const int sm = pm - 32; t0 = (sm & 7) * 256; kvrow0 = MP + (sm >> 3) * 2560 + t0; }
        const size_t m0 = (size_t)pm * 256;
        if (pn < 8 || (pn >= 12 && pn < 17)) {
            const float* gain; bf16_t* dst; int dstS; float* fo = nullptr; int foS = 0;
            if (pn < 4) { gain = gains; dst = QA + m0 * 1024 + pn * 256; dstS = 1024; }
            else if (pn < 8) { gain = gains + 64; dst = KA + (size_t)kvrow0 * 1024 + (pn - 4) * 256; dstS = 1024; if (prompt) { fo = o_dk + m0 * 1024 + (pn - 4) * 256; foS = 1024; } }
            else if (pn < 16) { gain = gains + 128; dst = QB + m0 * 1024 + (pn - 12) * 256; dstS = 1024; }
            else { gain = gains + 192; dst = KB + (size_t)kvrow0 * 256; dstS = 256; if (prompt) { fo = o_wk + m0 * 256; foS = 256; } }
            f32x4 gv[2][2];
#pragma unroll
            for (int bj = 0; bj < 2; ++bj)
#pragma unroll
                for (int n = 0; n < 2; ++n) gv[bj][n] = *(const f32x4*)(gain + 32 * n + 16 * bj + 4 * fq);
            float rstd8[8];
#pragma unroll
            for (int ai = 0; ai < 2; ++ai)
#pragma unroll
                for (int m = 0; m < 4; ++m) { float ss = 0.f;
#pragma unroll
                    for (int bj = 0; bj < 2; ++bj)
#pragma unroll
                        for (int n = 0; n < 2; ++n) { const f32x4 t = acc[ai][bj][m][n]; ss += (t.x * t.x + t.y * t.y) + (t.z * t.z + t.w * t.w); }
                    rstd8[ai * 4 + m] = ss; }
#pragma unroll
            for (int j = 0; j < 8; ++j) rstd8[j] += __shfl_xor(rstd8[j], 16);
#pragma unroll
            for (int j = 0; j < 8; ++j) rstd8[j] += __shfl_xor(rstd8[j], 32);
#pragma unroll
            for (int j = 0; j < 8; ++j) rstd8[j] = rsqrtf(rstd8[j] * (1.f / 64.f) + EPS);
            asm volatile("" ::: "memory"); __builtin_amdgcn_sched_barrier(0);
#pragma unroll
            for (int ai = 0; ai < 2; ++ai)
#pragma unroll
                for (int m = 0; m < 4; ++m) {
                    const int row = 128 * ai + 64 * wr + 16 * m + fr;
                    f32x4 y[2][2];
#pragma unroll
                    for (int bj = 0; bj < 2; ++bj)
#pragma unroll
                        for (int n = 0; n < 2; ++n) y[bj][n] = acc[ai][bj][m][n];
                    const float rstd = rstd8[ai * 4 + m];
#pragma unroll
                    for (int bj = 0; bj < 2; ++bj)
#pragma unroll
                        for (int n = 0; n < 2; ++n) y[bj][n] = y[bj][n] * rstd * gv[bj][n];
                    if (!prompt) {
                        const int t = t0 + row, grow = t >> 6, gcol = t & 63;
#pragma unroll
                        for (int n = 0; n < 2; ++n) { const int pos = n == 0 ? grow : gcol;
                            const f32x4 cs = *(const f32x4*)(rope + pos * 16 + 4 * fq), sn = *(const f32x4*)(rope + 1024 + pos * 16 + 4 * fq);
                            const f32x4 x1 = y[0][n], x2 = y[1][n];
                            y[0][n] = x1 * cs - x2 * sn; y[1][n] = x2 * cs + x1 * sn; }
                    }
#pragma unroll
                    for (int bj = 0; bj < 2; ++bj) { u32x4 o; o.x = pk2(y[bj][0].x, y[bj][0].y); o.y = pk2(y[bj][0].z, y[bj][0].w); o.z = pk2(y[bj][1].x, y[bj][1].y); o.w = pk2(y[bj][1].z, y[bj][1].w);
                        *(u32x4*)(dst + (size_t)row * dstS + 64 * wc + 32 * bj + 8 * fq) = o; }
                    if (fo) {
#pragma unroll
                        for (int bj = 0; bj < 2; ++bj)
#pragma unroll
                            for (int n = 0; n < 2; ++n) *(f32x4*)(fo + (size_t)row * foS + 64 * wc + 32 * n + 16 * bj + 4 * fq) = y[bj][n]; }
                    asm volatile("" ::: "memory"); __builtin_amdgcn_sched_barrier(0);
                }
        } else if (pn < 12 || pn == 17) {
            bf16_t* dst; int dstS; float* fo = nullptr;
            if (pn < 12) { dst = VA + (size_t)kvrow0 * 1024 + (pn - 8) * 256; dstS = 1024; if (prompt) fo = o_dv + m0 * 1024 + (pn - 8) * 256; }
            else { dst = VB + (size_t)kvrow0 * 256; dstS = 256; if (prompt) fo = o_wv + m0 * 256; }
#pragma unroll
            for (int ai = 0; ai < 2; ++ai)
#pragma unroll
                for (int m = 0; m < 4; ++m) { const int row = 128 * ai + 64 * wr + 16 * m + fr;
#pragma unroll
                    for (int bj = 0; bj < 2; ++bj) { const int col = 128 * bj + 32 * wc + 8 * fq; const f32x4 v0 = acc[ai][bj][m][0], v1 = acc[ai][bj][m][1];
                        u32x4 o; o.x = pk2(v0.x, v0.y); o.y = pk2(v0.z, v0.w); o.z = pk2(v1.x, v1.y); o.w = pk2(v1.z, v1.w);
                        *(u32x4*)(dst + (size_t)row * dstS + col) = o;
                        if (fo) { *(f32x4*)(fo + (size_t)row * dstS + col) = v0; *(f32x4*)(fo + (size_t)row * dstS + col + 4) = v1; } } }
        } else {
            bf16_t* dst = G + m0 * 2048 + (pn - 18) * 256;
#pragma unroll
            for (int ai = 0; ai < 2; ++ai)
#pragma unroll
                for (int m = 0; m < 4; ++m) { const int row = 128 * ai + 64 * wr + 16 * m + fr;
#pragma unroll
                    for (int bj = 0; bj < 2; ++bj) { const int col = 128 * bj + 32 * wc + 8 * fq; const f32x4 v0 = acc[ai][bj][m][0], v1 = acc[ai][bj][m][1];
                        u32x4 o; o.x = pk2(sigmoidf_(v0.x), sigmoidf_(v0.y)); o.y = pk2(sigmoidf_(v0.z), sigmoidf_(v0.w)); o.z = pk2(sigmoidf_(v1.x), sigmoidf_(v1.y)); o.w = pk2(sigmoidf_(v1.z), sigmoidf_(v1.w));
                        *(u32x4*)(dst + (size_t)row * 2048 + col) = o; } }
        }
    }
};
template <int MODE> struct EpiC8 {
    static constexpr bool PERM = true, AFTER_DRAIN = false;
    const bf16_t* G; float* T1; bf16_t* OB; const float* xp; const float* xs; const float* mod; float* X1;
    DI void operator()(const f32x4 (&acc)[2][2][4][2], const Unit& u, int wr, int wc, int fr, int fq) const {
        asm volatile("" : "+v"(fr), "+v"(fq));
        const int pn = u.pn, pm = u.pm; const size_t m0 = (size_t)pm * 256;
        const float* md = mod + (pm < 32 ? 0 : 1 + ((pm - 32) >> 3)) * 6144;
#pragma unroll
        for (int ai = 0; ai < 2; ++ai)
#pragma unroll
            for (int m = 0; m < 4; ++m) { const size_t row = m0 + 128 * ai + 64 * wr + 16 * m + fr;
                if (MODE == 4) { const int col = 128 * pn + 32 * wc + 8 * fq;
                    const f32x4 g0 = acc[ai][0][m][0], g1 = acc[ai][0][m][1], u0 = acc[ai][1][m][0], u1 = acc[ai][1][m][1];
                    u32x4 o; o.x = pk2(g0.x * sigmoidf_(g0.x) * u0.x, g0.y * sigmoidf_(g0.y) * u0.y); o.y = pk2(g0.z * sigmoidf_(g0.z) * u0.z, g0.w * sigmoidf_(g0.w) * u0.w);
                    o.z = pk2(g1.x * sigmoidf_(g1.x) * u1.x, g1.y * sigmoidf_(g1.y) * u1.y); o.w = pk2(g1.z * sigmoidf_(g1.z) * u1.z, g1.w * sigmoidf_(g1.w) * u1.w);
                    *(u32x4*)(OB + row * FF + col) = o;
                } else {
#pragma unroll
                    for (int bj = 0; bj < 2; ++bj) { const int col = 256 * pn + 128 * bj + 32 * wc + 8 * fq; const f32x4 v0 = acc[ai][bj][m][0], v1 = acc[ai][bj][m][1];
                        if (MODE == 0 || MODE == 1) {
                            const u32x4 gq = *(const u32x4*)(G + row * 2048 + (MODE == 1 ? 1024 : 0) + col);
                            const f32x4 ga = {bflo(gq.x), bfhi(gq.x), bflo(gq.y), bfhi(gq.y)}, gb = {bflo(gq.z), bfhi(gq.z), bflo(gq.w), bfhi(gq.w)};
                            bf16_t* T1b = (bf16_t*)T1;
                            if (MODE == 0) { const f32x4 t0 = ga * v0, t1 = gb * v1; u32x4 o; o.x = pk2(t0.x, t0.y); o.y = pk2(t0.z, t0.w); o.z = pk2(t1.x, t1.y); o.w = pk2(t1.z, t1.w); *(u32x4*)(T1b + row * D + col) = o; }
                            else { const u32x4 tq = *(const u32x4*)(T1b + row * D + col);
                                const f32x4 r0 = (f32x4){bflo(tq.x), bfhi(tq.x), bflo(tq.y), bfhi(tq.y)} + ga * v0, r1 = (f32x4){bflo(tq.z), bfhi(tq.z), bflo(tq.w), bfhi(tq.w)} + gb * v1;
                                u32x4 o; o.x = pk2(r0.x, r0.y); o.y = pk2(r0.z, r0.w); o.z = pk2(r1.x, r1.y); o.w = pk2(r1.z, r1.w); *(u32x4*)(OB + row * D + col) = o; }
                        } else if (MODE == 2) {
                            const int c0 = 256 * pn + 128 * bj + 32 * wc + 4 * fq;
                            const float* xr = row < MP ? xp + row * D : xs + (row - MP) * D;
                            const f32x4 g0 = *(const f32x4*)(md + 2048 + c0), g1 = *(const f32x4*)(md + 2048 + c0 + 16);
                            *(f32x4*)(X1 + row * D + c0) = *(const f32x4*)(xr + c0) + g0 * v0; *(f32x4*)(X1 + row * D + c0 + 16) = *(const f32x4*)(xr + c0 + 16) + g1 * v1;
                        } else {
                            const int c0 = 256 * pn + 128 * bj + 32 * wc + 4 * fq;
                            const f32x4 g0 = *(const f32x4*)(md + 5120 + c0), g1 = *(const f32x4*)(md + 5120 + c0 + 16);
                            float* xo = X1 + row * D + c0;
                            const f32x4 a0 = *(const f32x4*)xo, a1 = *(const f32x4*)(xo + 16);
                            *(f32x4*)xo = a0 + g0 * v0; *(f32x4*)(xo + 16) = a1 + g1 * v1;
                        } } } }
    }
};

DI float max3_(float a, float b, float c) { float r; asm("v_max3_f32 %0, %1, %2, %3" : "=v"(r) : "v"(a), "v"(b), "v"(c)); return r; }
template <int MODE>
DI void attn_unit(LAS unsigned char* lds, const bf16_t* Qw, bf16_t* Ow, const bf16_t* Kt, const bf16_t* Vt, int ra0, int ra1, int rb0, int rb1,
                  int qpos0, bool band, float sink_l2, float lam, const float* subg, int tid, int wave) {
    constexpr int KW = MODE == 0 ? 128 : 64, DV = KW, KS = MODE == 0 ? 1024 : 256;
    constexpr int KRS = KW * 2 + 16, VRS = DV * 2 + 64, KBYTES = 64 * KRS, VBYTES = 64 * VRS, VOFF = 2 * KBYTES;
    constexpr int CH = KW / 8, NL = 64 * CH / 512, NDV = DV / 32;
    constexpr float THR = 8.f;
    const int lane = tid & 63, h = lane >> 5, r = lane & 31;
    const int kc = MODE == 0 ? 64 * (wave >> 2) : 0;
    const int grp = wave >> 2;
    bf16x8 qf[4];
#pragma unroll
    for (int s = 0; s < 4; ++s) qf[s] = *(const bf16x8*)(Qw + (size_t)r * 1024 + 16 * s + 8 * h);
    f32x16 o[NDV], zero16, negm;
#pragma unroll
    for (int i = 0; i < 16; ++i) { zero16[i] = 0.f; negm[i] = 0.f; }
#pragma unroll
    for (int d = 0; d < NDV; ++d) o[d] = zero16;
    float mref = 0.f, lrun = 0.f; bool started = false, pact = false;
    bf16x8 pf[2][2];
#pragma unroll
    for (int a = 0; a < 2; ++a)
#pragma unroll
        for (int b = 0; b < 2; ++b) pf[a][b] = (bf16x8){0, 0, 0, 0, 0, 0, 0, 0};
    const int na = ra1 - ra0, nt = na + (rb1 - rb0);
    u32x4 kreg[NL], vreg[NL];
    const int q4 = (lane & 15) >> 2, p4 = lane & 3, blk = (lane >> 4) & 1;
    const unsigned goff = (unsigned)((tid / CH) * KS + (tid % CH) * 8) * 2u;
    const unsigned lks = (unsigned)((tid / CH) * KRS + (tid % CH) * 16), lvs = (unsigned)((tid / CH) * VRS + (tid % CH) * 16);
#define AT_KEY0(it) ((((it) < na) ? (ra0 + (it)) : (rb0 + (it) - na)) * 64)
#define AT_ACTIVE(key0_) (!((MODE == 1) && band && (key0_) < 2048) || (((key0_) + 63 >= qpos0 - 128) && ((key0_) <= qpos0 + 159)))
#define AT_GLOAD(it) do { const int key0_ = AT_KEY0(it); const char* kb_ = (const char*)(Kt + (size_t)key0_ * KS); const char* vb_ = (const char*)(Vt + (size_t)key0_ * KS); \
        _Pragma("unroll") for (int i_ = 0; i_ < NL; ++i_) { kreg[i_] = *(const u32x4*)(kb_ + (size_t)i_ * (512 / CH) * KS * 2 + goff); vreg[i_] = *(const u32x4*)(vb_ + (size_t)i_ * (512 / CH) * KS * 2 + goff); } } while (0)
#define AT_LSTORE(kb, vb) do { _Pragma("unroll") for (int i_ = 0; i_ < NL; ++i_) { \
        *(LAS u32x4*)(lds + (kb) * KBYTES + i_ * (512 / CH) * KRS + lks) = kreg[i_]; *(LAS u32x4*)(lds + VOFF + (vb) * VBYTES + i_ * (512 / CH) * VRS + lvs) = vreg[i_]; } } while (0)
#define AT_VREADK(F, ks) do { _Pragma("unroll") for (int d_ = 0; d_ < NDV; ++d_) { const LAS unsigned char* a_ = vbase + (16 * (ks)) * VRS + 64 * d_; \
        const s16x4 lo_ = vtr(a_), hi_ = vtr(a_ + 8 * VRS); F[d_] = __builtin_shufflevector(lo_, hi_, 0, 1, 2, 3, 4, 5, 6, 7); } } while (0)
#define AT_PVK(F, ks) do { __builtin_amdgcn_s_setprio(1); _Pragma("unroll") for (int d_ = 0; d_ < NDV; ++d_) o[d_] = MFMA32(F[d_], pf[(ks) >> 1][(ks) & 1], o[d_]); __builtin_amdgcn_s_setprio(0); } while (0)
#define AT_Y(VS) do { if (pact) { \
        const LAS unsigned char* vbase = lds + VOFF + (VS) * VBYTES + (4 * h + q4) * VRS + 32 * blk + 8 * p4; \
        bf16x8 vfa[NDV], vfb[NDV]; \
        AT_VREADK(vfa, 0); AT_VREADK(vfb, 1); __builtin_amdgcn_sched_barrier(0); \
        AT_PVK(vfa, 0); __builtin_amdgcn_sched_barrier(0); \
        AT_VREADK(vfa, 2); __builtin_amdgcn_sched_barrier(0); \
        AT_PVK(vfb, 1); __builtin_amdgcn_sched_barrier(0); \
        AT_VREADK(vfb, 3); __builtin_amdgcn_sched_barrier(0); \
        AT_PVK(vfa, 2); __builtin_amdgcn_sched_barrier(0); \
        AT_PVK(vfb, 3); __builtin_amdgcn_sched_barrier(0); \
        } } while (0)
    AT_GLOAD(0); AT_LSTORE(0, 0);
    __syncthreads();
    int vcur = 0, vprev = 2;
    for (int it = 0; it <= nt; ++it) {
        { const int tn_ = it + 1 < nt ? it + 1 : nt - 1; AT_GLOAD(tn_); }
        if (grp == 1) AT_Y(vprev);
        if (it < nt) {
            const int key0 = AT_KEY0(it);
            pact = AT_ACTIVE(key0);
            if (pact) {
                const LAS unsigned char* kl_ = lds + (it & 1) * KBYTES + r * KRS + (kc + 8 * h) * 2;
                bf16x8 kf0[4], kf1[4];
#pragma unroll
                for (int sd = 0; sd < 4; ++sd) { kf0[sd] = *(const LAS bf16x8*)(kl_ + 32 * sd); kf1[sd] = *(const LAS bf16x8*)(kl_ + 32 * KRS + 32 * sd); }
                __builtin_amdgcn_sched_barrier(0);
                f32x16 C0 = negm, C1 = negm;
                __builtin_amdgcn_s_setprio(1);
#pragma unroll
                for (int sd = 0; sd < 4; ++sd) { C0 = MFMA32(kf0[sd], qf[sd], C0); C1 = MFMA32(kf1[sd], qf[sd], C1); }
                __builtin_amdgcn_s_setprio(0);
                __builtin_amdgcn_sched_barrier(0);
                if ((MODE == 1) && band && key0 < 2048) { const int dq = key0 + 4 * h - (qpos0 + r);
#pragma unroll
                    for (int i = 0; i < 16; ++i) { const int d0 = dq + (i & 3) + 8 * (i >> 2), d1 = d0 + 32;
                        if (d0 < -128 || d0 > 128) C0[i] = -1e30f;
                        if (d1 < -128 || d1 > 128) C1[i] = -1e30f; } }
                float mx = max3_(C0[0], C1[0], C0[1]);
#pragma unroll
                for (int i = 1; i < 15; ++i) mx = max3_(mx, C1[i], C0[i + 1]);
                mx = fmaxf(mx, C1[15]);
                mx = fmaxf(mx, __shfl_xor(mx, 32));
                if (!started || __any(mx > THR)) {
                    const float dd = started ? fmaxf(mx, 0.f) : fmaxf(mx, -1e4f);
                    mref += dd;
#pragma unroll
                    for (int i = 0; i < 16; ++i) { C0[i] -= dd; C1[i] -= dd; negm[i] -= dd; }
                    if (started) { const float alpha = __builtin_amdgcn_exp2f(-dd); lrun *= alpha;
#pragma unroll
                        for (int d = 0; d < NDV; ++d) o[d] = o[d] * alpha; }
                    started = true;
                }
                float sum = 0.f;
#pragma unroll
                for (int i = 0; i < 16; ++i) { C0[i] = __builtin_amdgcn_exp2f(C0[i]); C1[i] = __builtin_amdgcn_exp2f(C1[i]); sum += C0[i] + C1[i]; }
                lrun += sum;
#pragma unroll
                for (int s = 0; s < 2; ++s) { u32x4 a, b;
                    a.x = pk2(C0[8 * s + 0], C0[8 * s + 1]); a.y = pk2(C0[8 * s + 2], C0[8 * s + 3]); a.z = pk2(C0[8 * s + 4], C0[8 * s + 5]); a.w = pk2(C0[8 * s + 6], C0[8 * s + 7]);
                    b.x = pk2(C1[8 * s + 0], C1[8 * s + 1]); b.y = pk2(C1[8 * s + 2], C1[8 * s + 3]); b.z = pk2(C1[8 * s + 4], C1[8 * s + 5]); b.w = pk2(C1[8 * s + 6], C1[8 * s + 7]);
                    pf[0][s] = __builtin_bit_cast(bf16x8, a); pf[1][s] = __builtin_bit_cast(bf16x8, b); }
            }
            if (grp == 0) AT_Y(vcur);
        }
        { const int vn_ = vcur == 2 ? 0 : vcur + 1; AT_LSTORE((it + 1) & 1, vn_); vprev = vcur; vcur = vn_; }
        __syncthreads();
    }
#undef AT_KEY0
#undef AT_ACTIVE
#undef AT_GLOAD
#undef AT_LSTORE
#undef AT_VREADK
#undef AT_PVK
#undef AT_Y
    float ltot = lrun + __shfl_xor(lrun, 32);
    if (MODE == 1) ltot += __builtin_amdgcn_exp2f(sink_l2 - mref);
    const float inv = 1.f / ltot;
#pragma unroll
    for (int d = 0; d < NDV; ++d) o[d] = o[d] * inv;
    if (MODE == 1) {
#pragma unroll
        for (int d = 0; d < NDV; ++d)
#pragma unroll
            for (int g = 0; g < 4; ++g) { u32x2 w; w.x = pk2(o[d][4 * g], o[d][4 * g + 1]); w.y = pk2(o[d][4 * g + 2], o[d][4 * g + 3]);
                *(u32x2*)(Ow + (size_t)r * 1024 + 32 * d + 8 * g + 4 * h) = w; }
    } else {
        LAS float* ex = (LAS float*)lds;
        if (wave >= 4) {
#pragma unroll
            for (int d = 0; d < NDV; ++d)
#pragma unroll
                for (int i = 0; i < 16; ++i) ex[((wave - 4) * (NDV * 16) + d * 16 + i) * 64 + lane] = o[d][i];
        }
        __syncthreads();
        if (wave < 4) {
            float ss = 0.f;
#pragma unroll
            for (int d = 0; d < NDV; ++d)
#pragma unroll
                for (int i = 0; i < 16; ++i) { const float v = o[d][i] - lam * ex[(wave * (NDV * 16) + d * 16 + i) * 64 + lane]; o[d][i] = v; ss += v * v; }
            ss += __shfl_xor(ss, 32);
            const float rstd = rsqrtf(ss * (1.f / 128.f) + EPS) * 0.8f;
#pragma unroll
            for (int d = 0; d < NDV; ++d)
#pragma unroll
                for (int g = 0; g < 4; ++g) { const f32x4 gg = *(const f32x4*)(subg + 32 * d + 8 * g + 4 * h);
                    u32x2 w; w.x = pk2(o[d][4 * g] * rstd * gg.x, o[d][4 * g + 1] * rstd * gg.y); w.y = pk2(o[d][4 * g + 2] * rstd * gg.z, o[d][4 * g + 3] * rstd * gg.w);
                    *(u32x2*)(Ow + (size_t)r * 1024 + 32 * d + 8 * g + 4 * h) = w; }
        }
    }
}

#define XB_TMO      128
#define XB_XCNT(j)  (256  + 64 * (j))
#define XB_XSUB(j)  (1280 + 64 * (j))
#define XB_XGEN(j)  (2304 + 64 * (j))
#define XB_TOP      3328
#define XB_TOPGEN   3392
#define XCD_BAR_WORDS 3456
#define XB_SPIN_CAP (1u << 18)

__device__ __forceinline__ unsigned xb_ld(unsigned* p)              { return __hip_atomic_load(p, __ATOMIC_RELAXED, __HIP_MEMORY_SCOPE_AGENT); }
__device__ __forceinline__ unsigned xb_add(unsigned* p, unsigned v) { return __hip_atomic_fetch_add(p, v, __ATOMIC_RELAXED, __HIP_MEMORY_SCOPE_AGENT); }
__device__ __forceinline__ unsigned xb_xcc_id() { return (unsigned)__builtin_amdgcn_s_getreg((3 << 11) | 20) & 0xFu; }
#define XB_SPIN(cond, bar) do { unsigned _sp = 0; while (cond) { __builtin_amdgcn_s_sleep(1); \
    if ((++_sp & 255u) == 0u) { if (xb_ld(&(bar)[XB_TMO])) break; if (_sp > XB_SPIN_CAP) { atomicAdd(&(bar)[XB_TMO], 1u); break; } } } } while (0)

struct XcdBarrier {
    unsigned* bar; unsigned x;
    volatile LAS unsigned* st;
};

__device__ __forceinline__ XcdBarrier xcd_barrier_post(unsigned* bar, volatile LAS unsigned* st) {
    XcdBarrier b; b.bar = bar; b.x = xb_xcc_id(); b.st = st;
    if (threadIdx.x == 0) (void)xb_add(&bar[XB_XCNT(b.x)], 1u);
    return b;
}
__device__ __forceinline__ void xcd_barrier_complete(unsigned* bar, unsigned x, unsigned& nloc, unsigned& nx) {
    const unsigned G = gridDim.x * gridDim.y * gridDim.z;
    unsigned sum, cnt, mine, sp = 0u;
    for (;;) {
        sum = 0u; cnt = 0u; mine = 0u;
#pragma unroll
        for (unsigned j = 0; j < 16; ++j) { const unsigned c = xb_ld(&bar[XB_XCNT(j)]); sum += c; cnt += (c > 0u) ? 1u : 0u; mine = (j == x) ? c : mine; }
        if (sum == G) break;
        __builtin_amdgcn_s_sleep(1);
        if ((++sp & 255u) == 0u) { if (xb_ld(&bar[XB_TMO])) break; if (sp > XB_SPIN_CAP) { atomicAdd(&bar[XB_TMO], 1u); break; } }
    }
    nloc = mine > 0u ? mine : 1u; nx = cnt > 0u ? cnt : 1u;
}

__device__ __forceinline__ void xcd_barrier(const XcdBarrier& b) {
    asm volatile("s_waitcnt vmcnt(0)" ::: "memory");
    __syncthreads();
    if (threadIdx.x == 0) {
        unsigned* bar = b.bar;
        __builtin_amdgcn_s_waitcnt(0);
        unsigned nloc = b.st[0], nx = b.st[1];
        if (nloc == 0u) { xcd_barrier_complete(bar, b.x, nloc, nx); b.st[0] = nloc; b.st[1] = nx; }
        const unsigned old = xb_add(&bar[XB_XSUB(b.x)], 1u);
        const unsigned gen = old / nloc;
        if (old + 1u == (gen + 1u) * nloc) {
            __builtin_amdgcn_fence(__ATOMIC_RELEASE, "agent");
            asm volatile("s_waitcnt vmcnt(0)" ::: "memory");
            const unsigned og = xb_add(&bar[XB_TOP], 1u);
            const unsigned tg = og / nx;
            if (og + 1u == (tg + 1u) * nx) xb_add(&bar[XB_TOPGEN], 1u);
            else XB_SPIN(xb_ld(&bar[XB_TOPGEN]) == tg, bar);
            __builtin_amdgcn_fence(__ATOMIC_ACQUIRE, "agent");
            xb_add(&bar[XB_XGEN(b.x)], 1u);
            asm volatile("s_waitcnt vmcnt(0)" ::: "memory");
        } else {
            XB_SPIN(xb_ld(&bar[XB_XGEN(b.x)]) == gen, bar);
            __builtin_amdgcn_fence(__ATOMIC_ACQUIRE, "agent");
            asm volatile("s_waitcnt vmcnt(0)" ::: "memory");
        }
    }
    __syncthreads();
}

__global__ void __launch_bounds__(512, 2) fwd_kernel(Params p) {
    extern __shared__ __attribute__((aligned(16))) unsigned char lds_raw[];
    LAS unsigned char* lds = (LAS unsigned char*)lds_raw;
    cg::grid_group grid = cg::this_grid();
    const int tid = threadIdx.x, lane = tid & 63, wave = __builtin_amdgcn_readfirstlane(tid >> 6);
    const int G = gridDim.x, bx = blockIdx.x;
    const int gw = bx * 8 + wave, ngw = G * 8, gtid = bx * 512 + tid, nthr = G * 512;
    unsigned char* ws = p.ws;
    float* mod = (float*)(ws + WS_MOD); const float* rope = (const float*)(ws + WS_ROPE);
    bf16_t *WIN = (bf16_t*)(ws + WS_WIN), *WOA = (bf16_t*)(ws + WS_WOA), *WOB = (bf16_t*)(ws + WS_WOB), *WOUT = (bf16_t*)(ws + WS_WOUT), *WGU = (bf16_t*)(ws + WS_WGU), *WDN = (bf16_t*)(ws + WS_WDN);
    bf16_t *H = (bf16_t*)(ws + WS_H), *QA = (bf16_t*)(ws + WS_QA), *QB = (bf16_t*)(ws + WS_QB), *KA = (bf16_t*)(ws + WS_KA), *VA = (bf16_t*)(ws + WS_VA), *KB = (bf16_t*)(ws + WS_KB), *VB = (bf16_t*)(ws + WS_VB);
    float* T1 = (float*)(ws + WS_T1); bf16_t* ACT = (bf16_t*)(ws + WS_ACT);
    bf16_t* Gt = (bf16_t*)p.out;
    float* X1 = p.out;

    volatile LAS unsigned* bst = (volatile LAS unsigned*)(lds + 131072 + 64);
    if (tid < 2) bst[tid] = 0u;
    if (bx == 0) for (int i = tid; i < XCD_BAR_WORDS; i += 512) ((unsigned*)(ws + WS_BAR))[i] = 0u;
    grid.sync();
    const XcdBarrier xbar = xcd_barrier_post((unsigned*)(ws + WS_BAR), bst);
    for (int task = bx; task < 193; task += G) p0_mod_task(p, task, lds, tid);
    __syncthreads();
    {
        LAS float* scr = (LAS float*)(lds + wave * 16384);
        constexpr int I_IN = 16 * (NIN / 32), I_SQ = 16 * 32, I_FF = 16 * (FF / 32), I_DN = (FF / 64) * 32;
        constexpr int NITEMS = I_IN;
        for (int it0 = gw; it0 < NITEMS; it0 += ngw) transpose_item(p.w_in, D, NIN, WIN, -1, scr, it0, lane);
    }
    xcd_barrier(xbar);
    norm_rows(p.x_prompt, p.x_sample, p.norm1_g, mod, 0, 1024, H, gw, ngw, lane);
    xcd_barrier(xbar);
#ifndef SKIP_P2
    {
        pg8::Gemm g{H, WIN, M, NIN, D}; pg8::StaticOrder S; S.init(M, NIN, G, bx);
        EpiIn E{ws, p.out};
        pg8::gemm_phase<EpiIn, pg8::StaticOrder, true, true>(lds, g, S, E);
        const int nfull = (M / 256) * (NIN / 256) - (((M / 256) * (NIN / 256)) / G) * G;
        if (bx >= nfull) {
            __syncthreads();
            LAS float* scr = (LAS float*)(lds + wave * 16384);
            constexpr int I_FF = 16 * (FF / 32), I_DN = (FF / 64) * 32, I_SQ = 16 * 32;
            const int nidle = G - nfull;
            for (int it0 = (bx - nfull) * 8 + wave; it0 < 3 * I_SQ + 2 * I_FF; it0 += nidle * 8) {
                int it = it0;
                if (it < I_SQ) { transpose_item(p.w_oa, D, D, WOA, 0, scr, it, lane); continue; } it -= I_SQ;
                if (it < I_SQ) { transpose_item(p.w_ob, D, D, WOB, 0, scr, it, lane); continue; } it -= I_SQ;
                if (it < I_SQ) { transpose_item(p.w_out, D, D, WOUT, 5, scr, it, lane); continue; } it -= I_SQ;
                if (it < I_FF) { transpose_item(p.w_gate, D, FF, WGU, 2, scr, it, lane); continue; } it -= I_FF;
                transpose_item(p.w_up, D, FF, WGU, 3, scr, it - 0, lane);
            }
            const int itid = (bx - nfull) * 512 + tid, inthr = nidle * 512;
            for (int b = 0; b < 4; ++b) {
                const size_t kvr = (size_t)(MP + b * 2560 + 2048);
                convert_span_perm(p.cdk + (size_t)b * 512 * 1024, KA + kvr * 1024, 512 * 1024 / 4, itid, inthr);
                convert_span(p.cdv + (size_t)b * 512 * 1024, VA + kvr * 1024, 512 * 1024 / 4, itid, inthr);
                convert_span_perm(p.cwk + (size_t)b * 512 * 256, KB + kvr * 256, 512 * 256 / 4, itid, inthr);
                convert_span(p.cwv + (size_t)b * 512 * 256, VB + kvr * 256, 512 * 256 / 4, itid, inthr);
            }
        }
    }
#endif
    xcd_barrier(xbar);
#ifndef SKIP_P3
    {
        const float lam = *(const float*)(ws + WS_LAM);
        for (int u = bx; u < 2048; u += G) {
            const int kind = u >> 9, v = u & 511, rr = v >> 8, cc = v & 255, xcd = cc & 7, slot = cc >> 3;
            int tid = threadIdx.x; asm volatile("" : "+v"(tid));
            __syncthreads();
            if (kind == 0) {
                const int bh = rr * 16 + xcd * 2 + (slot >> 4), qblk = slot & 15, b = bh >> 3, hh = bh & 7;
                const size_t rows = (size_t)MP + b * 2048 + qblk * 128 + 32 * (wave & 3), kv0 = (size_t)MP + b * 2560;
                attn_unit<0>(lds, QA + rows * 1024 + hh * 128 + 64 * (wave >> 2), QA + rows * 1024 + hh * 128, KA + kv0 * 1024 + hh * 128, VA + kv0 * 1024 + hh * 128,
                             0, 40, 0, 0, 0, false, 0.f, lam, p.subln_g, tid, wave);
            } else if (kind == 1) {
                const int bg = rr * 8 + xcd, hin = slot >> 3, qblk = slot & 7, b = bg >> 2, g4 = bg & 3, hq = g4 * 4 + hin;
                const size_t rows = (size_t)MP + b * 2048 + qblk * 256 + 32 * wave, kv0 = (size_t)MP + b * 2560;
                const int lo = 4 * qblk - 2 < 0 ? 0 : 4 * qblk - 2, hi = 4 * qblk + 6 > 32 ? 32 : 4 * qblk + 6;
                attn_unit<1>(lds, QB + rows * 1024 + hq * 64, QB + rows * 1024 + hq * 64, KB + kv0 * 256 + g4 * 64, VB + kv0 * 256 + g4 * 64,
                             32, 40, lo, hi, qblk * 256 + 32 * wave, true, p.sink[hq] * LOG2E, lam, p.subln_g, tid, wave);
            } else if (kind == 2) {
                const int b = v >> 4, hh = (v >> 1) & 7, half = v & 1;
                const size_t rows = (size_t)b * 256 + half * 128 + 32 * (wave & 3), kv0 = (size_t)b * 256;
                attn_unit<0>(lds, QA + rows * 1024 + hh * 128 + 64 * (wave >> 2), QA + rows * 1024 + hh * 128, KA + kv0 * 1024 + hh * 128, VA + kv0 * 1024 + hh * 128,
                             0, 4, 0, 0, 0, false, 0.f, lam, p.subln_g, tid, wave);
            } else {
                const int b = v >> 4, hq = v & 15, g4 = hq >> 2;
                const size_t rows = (size_t)b * 256 + 32 * wave, kv0 = (size_t)b * 256;
                attn_unit<1>(lds, QB + rows * 1024 + hq * 64, QB + rows * 1024 + hq * 64, KB + kv0 * 256 + g4 * 64, VB + kv0 * 256 + g4 * 64,
                             0, 4, 0, 0, 0, false, p.sink[hq] * LOG2E, lam, p.subln_g, tid, wave);
            }
        }
    }
#endif
    xcd_barrier(xbar);
#ifndef SKIP_P4
    {
        pg8::StaticOrder S; S.init(M, D, G, bx);
        { pg8::Gemm g{QA, WOA, M, D, D}; EpiC8<0> E{Gt, T1, nullptr, nullptr, nullptr, mod, nullptr}; pg8::gemm_phase<EpiC8<0>, pg8::StaticOrder, true, true>(lds, g, S, E); }
        __syncthreads();
        { pg8::Gemm g{QB, WOB, M, D, D}; EpiC8<1> E{Gt, T1, H, nullptr, nullptr, mod, nullptr}; pg8::gemm_phase<EpiC8<1>, pg8::StaticOrder, true, true>(lds, g, S, E); }
    }
#endif
    xcd_barrier(xbar);
#ifndef SKIP_P5
    {
        pg8::Gemm g{H, WOUT, M, D, D}; pg8::StaticOrder S; S.init(M, D, G, bx);
        EpiC8<2> E{nullptr, nullptr, nullptr, p.x_prompt, p.x_sample, mod, X1};
        pg8::gemm_phase<EpiC8<2>, pg8::StaticOrder, true, true>(lds, g, S, E);
    }
#endif
    xcd_barrier(xbar);
    norm_rows(X1, X1 + (size_t)MP * D, p.norm2_g, mod, 3072, 4096, H, gw, ngw, lane);
    xcd_barrier(xbar);
#ifndef SKIP_P7
    {
        pg8::Gemm g{H, WGU, M, 2 * FF, D}; pg8::StaticOrder S; S.init(M, 2 * FF, G, bx);
        EpiC8<4> E{nullptr, nullptr, ACT, nullptr, nullptr, mod, nullptr};
        pg8::gemm_phase<EpiC8<4>, pg8::StaticOrder, true, true>(lds, g, S, E);
        const int nwg7 = (M / 256) * (2 * FF / 256), nfull7 = nwg7 - (nwg7 / G) * G;
        if (bx >= nfull7) {
            __syncthreads();
            LAS float* scr = (LAS float*)(lds + wave * 16384);
            constexpr int I_DN = (FF / 64) * 32;
            const int nidle = G - nfull7;
            for (int it0 = (bx - nfull7) * 8 + wave; it0 < I_DN; it0 += nidle * 8) transpose_item(p.w_down, FF, D, WDN, 5, scr, it0, lane);
        }
    }
#endif
    xcd_barrier(xbar);
#ifndef SKIP_P8
    {
        pg8::Gemm g{ACT, WDN, M, D, FF}; pg8::StaticOrder S; S.init(M, D, G, bx);
        EpiC8<3> E{nullptr, nullptr, nullptr, nullptr, nullptr, mod, X1};
        pg8::gemm_phase<EpiC8<3>, pg8::StaticOrder, true, true>(lds, g, S, E);
    }
#endif
}

extern "C" void kernel_launch(void* const* d_in, const int* in_sizes, int n_in, void* d_out, int out_size, void* d_ws, size_t ws_size, hipStream_t stream) {
    static int grid = 0;
    if (grid == 0) {
        if (n_in != 29 || ws_size < WS_END) { fprintf(stderr, "kernel_launch: unexpected n_in %d / ws %zu\n", n_in, ws_size); grid = -1; return; }
        int dev = 0, cus = 0, per_cu = 0;
        (void)hipGetDevice(&dev); (void)hipDeviceGetAttribute(&cus, hipDeviceAttributeMultiprocessorCount, dev);
        if (hipFuncSetAttribute((const void*)fwd_kernel, hipFuncAttributeMaxDynamicSharedMemorySize, LDS_BYTES) != hipSuccess) fprintf(stderr, "kernel_launch: hipFuncSetAttribute failed\n");
        if (hipOccupancyMaxActiveBlocksPerMultiprocessor(&per_cu, (const void*)fwd_kernel, 512, LDS_BYTES) != hipSuccess || per_cu < 1) { fprintf(stderr, "kernel_launch: occupancy query gave %d\n", per_cu); per_cu = 1; }
        (void)hipGetLastError();
        grid = cus > 0 ? cus : 256;
    }
    if (grid < 0) return;
    Params p{};
    const float** pp = (const float**)&p;
    for (int i = 0; i < 29; ++i) pp[i] = (const float*)d_in[i];
    p.out = (float*)d_out; p.ws = (unsigned char*)d_ws;
    void* args[] = {&p};
    hipError_t e = hipLaunchCooperativeKernel((const void*)fwd_kernel, dim3(grid), dim3(512), args, LDS_BYTES, stream);
    if (e != hipSuccess) fprintf(stderr, "cooperative launch failed: %s (grid %d)\n", hipGetErrorString(e), grid);
}
```

```cpp
#include <hip/hip_runtime.h>
#include <hip/hip_cooperative_groups.h>
#include <cstdio>
#include <cstdint>
namespace cg = cooperative_groups;
namespace pg8 {
#define PG8_LAS __attribute__((address_space(3)))
typedef unsigned short bf16_t;
typedef short bf16x8 __attribute__((ext_vector_type(8)));
typedef float f32x4 __attribute__((ext_vector_type(4)));
typedef unsigned u32x4 __attribute__((ext_vector_type(4)));
constexpr int BM = 256, BK = 64, HALF = 128, HTB = HALF * BK * 2  , STAGE_BYTES = 8 * HTB, NXCD = 8, WGM = 4;

__host__ __device__ __forceinline__ int lds_byte(int r, int c) { const int st = (r >> 4) * 2 + (c >> 5), rr = r & 15, cc = c & 31, ob = rr * 64 + cc * 2; return st * 1024 + (ob ^ (((ob >> 9) & 1) << 5)); }
__host__ __device__ __forceinline__ void stage_rc(int b, int& R, int& C) { const int st = b / 1024, sb = b % 1024, swz = sb ^ (((sb >> 9) & 1) << 5); R = (st >> 1) * 16 + swz / 64; C = (st & 1) * 32 + (swz % 64) / 2; }
__host__ __device__ __forceinline__ int perm32(int rho) { const int n = rho >> 4, i = rho & 15; return 8 * (i >> 2) + 4 * n + (i & 3); }

struct Unit { int pm, pn; };
struct Gemm { const bf16_t* A; const bf16_t* Bt; int M, N, K; };

struct StaticOrder {
    int nM, nN, nwg, G, c;
    __host__ __device__ void init(int M, int N, int G_, int c_) { nM = M / BM; nN = N / BM; nwg = nM * nN; G = G_; c = c_; }
    __host__ __device__ bool next(int i, Unit& u) const {
        const long L = (long)i * G + c; if (L >= nwg) return false;
        int wgid = (int)L; { const int q = nwg / NXCD, r = nwg % NXCD, xcd = wgid % NXCD, off = wgid / NXCD; wgid = (xcd < r ? xcd * (q + 1) : r * (q + 1) + (xcd - r) * q) + off; }
        const int nig = WGM * nN, gid = wgid / nig, fm = gid * WGM, gsz = (nM - fm) < WGM ? (nM - fm) : WGM;
        u.pm = fm + ((wgid % nig) % gsz); u.pn = (wgid % nig) / gsz; return true;
    }
    __device__ __forceinline__ void a_ready(const Unit&) const {}
    __device__ __forceinline__ void done(const Unit&) const {}
};

__device__ __forceinline__ unsigned cvt_pk_bf16(float lo, float hi) { unsigned r; asm volatile("v_cvt_pk_bf16_f32 %0, %1, %2" : "=v"(r) : "v"(lo), "v"(hi)); return r; }

template <class Epi, class Sched, bool ALIGN_EPI = false, bool SP2 = false>
__device__ __forceinline__ void gemm_phase(PG8_LAS unsigned char* lds, const Gemm g, const Sched& S, const Epi& E) {
    int tid = threadIdx.x; asm volatile("" : "+v"(tid));
    const int wid = __builtin_amdgcn_readfirstlane(tid >> 6), lane = tid & 63, wr = wid >> 2, wc = wid & 3, fr = lane & 15, fq = lane >> 4;
    const int K = g.K, nt = K / BK;
    unsigned voffA[2], voffB[2];
#pragma unroll
    for (int i = 0; i < 2; ++i) { int R, C; stage_rc(tid * 16 + i * 8192, R, C); const int Rb = Epi::PERM ? ((R & ~31) + perm32(R & 31)) : R;
        voffA[i] = (unsigned)(R * K + C) * 2u; voffB[i] = (unsigned)(Rb * K + C) * 2u; }
    const size_t kstep = (size_t)(BK * 2);
    const size_t hstep = (size_t)HALF * K * 2;
    const size_t tstep = 2 * hstep;
    const unsigned ldsw = (unsigned)wid * 1024u;
    const int aoff = lds_byte(wr * 64 + fr, fq * 8), boff = lds_byte(wc * 32 + fr, fq * 8);
#define PG8_SA(b, h) (((b) * 2 + (h)) * HTB)
#define PG8_SB(b, h) ((4 + (b) * 2 + (h)) * HTB)
#define PG8_STAGE(bufoff, gbase, voff) do { _Pragma("unroll") for (int _i = 0; _i < 2; ++_i) \
        __builtin_amdgcn_global_load_lds((const unsigned*)((const char*)(gbase) + (voff)[_i]), (PG8_LAS unsigned*)(lds + (bufoff) + ldsw + _i * 8192), 16, 0, 0); } while (0)
#define PG8_LDA(dst, b, h) do { _Pragma("unroll") for (int m = 0; m < 4; ++m) _Pragma("unroll") for (int k = 0; k < 2; ++k) dst[m][k] = *(const PG8_LAS bf16x8*)(lds + PG8_SA(b, h) + aoff + m * 2048 + k * 1024); } while (0)
#define PG8_LDB(dst, b, h) do { _Pragma("unroll") for (int n = 0; n < 2; ++n) _Pragma("unroll") for (int k = 0; k < 2; ++k) dst[n][k] = *(const PG8_LAS bf16x8*)(lds + PG8_SB(b, h) + boff + n * 2048 + k * 1024); } while (0)
#define PG8_MMA(ai, bj, At, Bt) do { __builtin_amdgcn_s_setprio(1); _Pragma("unroll") for (int m = 0; m < 4; ++m) _Pragma("unroll") for (int n = 0; n < 2; ++n) _Pragma("unroll") for (int k = 0; k < 2; ++k) \
        acc[ai][bj][m][n] = __builtin_amdgcn_mfma_f32_16x16x32_bf16(Bt[n][k], At[m][k], acc[ai][bj][m][n], 0, 0, 0); __builtin_amdgcn_s_setprio(0); } while (0)
#define PG8_WAIT_V(n) asm volatile("s_waitcnt vmcnt(" #n ")" ::: "memory")
#define PG8_WAIT_L(n) asm volatile("s_waitcnt lgkmcnt(" #n ")" ::: "memory")
#define PG8_BAR __builtin_amdgcn_s_barrier()
#define PG8_SCHED __builtin_amdgcn_sched_barrier(0)
    Unit cur, nxt; int ui = 0;
    if (!S.next(0, cur)) return;
    f32x4 acc[2][2][4][2];
#pragma unroll
    for (int a = 0; a < 2; ++a)
#pragma unroll
        for (int b = 0; b < 2; ++b)
#pragma unroll
            for (int m = 0; m < 4; ++m)
#pragma unroll
                for (int n = 0; n < 2; ++n) acc[a][b][m][n] = (f32x4){0.f, 0.f, 0.f, 0.f};
    bf16x8 At[4][2], B0[2][2], B1[2][2];
    const char* cA = (const char*)g.A + (size_t)cur.pm * tstep; const char* cB = (const char*)g.Bt + (size_t)cur.pn * tstep;
    S.a_ready(cur);
    if constexpr (SP2) {
        PG8_STAGE(PG8_SB(0, 0), cB, voffB); PG8_STAGE(PG8_SB(0, 1), cB + hstep, voffB); PG8_STAGE(PG8_SA(0, 0), cA, voffA); PG8_STAGE(PG8_SA(0, 1), cA + hstep, voffA);
        if (wr == 1) PG8_BAR;
        PG8_WAIT_V(2); PG8_BAR;
        PG8_STAGE(PG8_SB(1, 0), cB + kstep, voffB); PG8_STAGE(PG8_SA(1, 0), cA + kstep, voffA); PG8_STAGE(PG8_SB(1, 1), cB + hstep + kstep, voffB);
        PG8_WAIT_V(6); PG8_BAR;
    } else {
        PG8_STAGE(PG8_SB(0, 0), cB, voffB); PG8_STAGE(PG8_SA(0, 0), cA, voffA); PG8_STAGE(PG8_SB(0, 1), cB + hstep, voffB); PG8_STAGE(PG8_SA(0, 1), cA + hstep, voffA);
        if (wr == 1) PG8_BAR;
        PG8_WAIT_V(4); PG8_BAR;
        PG8_STAGE(PG8_SB(1, 0), cB + kstep, voffB); PG8_STAGE(PG8_SA(1, 0), cA + kstep, voffA); PG8_STAGE(PG8_SB(1, 1), cB + hstep + kstep, voffB);
        PG8_WAIT_V(6); PG8_BAR;
    }
    for (;;) {
        const bool has_next = S.next(ui + 1, nxt);
        const char* nA = has_next ? (const char*)g.A + (size_t)nxt.pm * tstep : cA; const char* nB = has_next ? (const char*)g.Bt + (size_t)nxt.pn * tstep : cB;
        for (int t = 0; t < nt; t += 2) {
            const bool last = (t == nt - 2);
            const char* a1 = cA + (size_t)(t + 1) * kstep;
            const char* a2 = last ? nA : cA + (size_t)(t + 2) * kstep; const char* b2 = last ? nB : cB + (size_t)(t + 2) * kstep;
            const char* a3 = a2 + kstep; const char* b3 = b2 + kstep;
            if (last && has_next) S.a_ready(nxt);
            if constexpr (SP2) {
            PG8_LDB(B0, 0, 0); PG8_LDB(B1, 0, 1); PG8_SCHED; PG8_LDA(At, 0, 0); PG8_STAGE(PG8_SA(1, 1), a1 + hstep, voffA);
            PG8_WAIT_V(8); PG8_WAIT_L(0); PG8_BAR; PG8_MMA(0, 0, At, B0); PG8_MMA(0, 1, At, B1); PG8_BAR; PG8_SCHED;
            PG8_LDA(At, 0, 1); PG8_STAGE(PG8_SB(0, 0), b2, voffB); PG8_STAGE(PG8_SB(0, 1), b2 + hstep, voffB); PG8_STAGE(PG8_SA(0, 0), a2, voffA);
            PG8_WAIT_V(8); PG8_WAIT_L(0); PG8_BAR; PG8_MMA(1, 0, At, B0); PG8_MMA(1, 1, At, B1); PG8_BAR; PG8_SCHED;
            PG8_LDB(B0, 1, 0); PG8_LDB(B1, 1, 1); PG8_SCHED; PG8_LDA(At, 1, 0); PG8_STAGE(PG8_SA(0, 1), a2 + hstep, voffA);
            PG8_WAIT_V(8); PG8_WAIT_L(0); PG8_BAR; PG8_MMA(0, 0, At, B0); PG8_MMA(0, 1, At, B1); PG8_BAR; PG8_SCHED;
            PG8_LDA(At, 1, 1); PG8_STAGE(PG8_SB(1, 0), b3, voffB); PG8_STAGE(PG8_SB(1, 1), b3 + hstep, voffB); PG8_STAGE(PG8_SA(1, 0), a3, voffA);
            PG8_WAIT_V(8); PG8_WAIT_L(0); PG8_BAR; PG8_MMA(1, 0, At, B0); PG8_MMA(1, 1, At, B1); PG8_BAR; PG8_SCHED;
            } else {
            PG8_LDB(B0, 0, 0); PG8_SCHED; PG8_LDA(At, 0, 0); PG8_STAGE(PG8_SA(1, 1), a1 + hstep, voffA);
            PG8_WAIT_L(8); PG8_BAR; PG8_WAIT_L(0); PG8_MMA(0, 0, At, B0); PG8_BAR; PG8_SCHED;
            PG8_LDB(B1, 0, 1); PG8_STAGE(PG8_SB(0, 0), b2, voffB);
            PG8_BAR; PG8_WAIT_L(0); PG8_MMA(0, 1, At, B1); PG8_BAR;
            PG8_LDA(At, 0, 1); PG8_STAGE(PG8_SA(0, 0), a2, voffA);
            PG8_BAR; PG8_WAIT_L(0); PG8_MMA(1, 0, At, B0); PG8_BAR; PG8_SCHED;
            PG8_STAGE(PG8_SB(0, 1), b2 + hstep, voffB);
            PG8_WAIT_V(6); PG8_BAR; PG8_MMA(1, 1, At, B1); PG8_BAR;
            PG8_LDB(B0, 1, 0); PG8_SCHED; PG8_LDA(At, 1, 0); PG8_STAGE(PG8_SA(0, 1), a2 + hstep, voffA);
            PG8_WAIT_L(8); PG8_BAR; PG8_WAIT_L(0); PG8_MMA(0, 0, At, B0); PG8_BAR; PG8_SCHED;
            PG8_LDB(B1, 1, 1); PG8_STAGE(PG8_SB(1, 0), b3, voffB);
            PG8_BAR; PG8_WAIT_L(0); PG8_MMA(0, 1, At, B1); PG8_BAR;
            PG8_LDA(At, 1, 1); PG8_STAGE(PG8_SA(1, 0), a3, voffA);
            PG8_BAR; PG8_WAIT_L(0); PG8_MMA(1, 0, At, B0); PG8_BAR; PG8_SCHED;
            PG8_STAGE(PG8_SB(1, 1), b3 + hstep, voffB);
            PG8_WAIT_V(6); PG8_BAR; PG8_MMA(1, 1, At, B1); PG8_BAR;
            }
        }
        if constexpr (ALIGN_EPI) { if (wr == 0) PG8_BAR; }
        if constexpr (!Epi::AFTER_DRAIN) { E(acc, cur, wr, wc, fr, fq); S.done(cur); }
        if (!has_next) break;
#pragma unroll
        for (int a = 0; a < 2; ++a)
#pragma unroll
            for (int b = 0; b < 2; ++b)
#pragma unroll
                for (int m = 0; m < 4; ++m)
#pragma unroll
                    for (int n = 0; n < 2; ++n) acc[a][b][m][n] = (f32x4){0.f, 0.f, 0.f, 0.f};
        cur = nxt; cA = nA; cB = nB; ++ui;
        if constexpr (ALIGN_EPI) { if (wr == 1) PG8_BAR; }
    }
    PG8_WAIT_V(0);
    if constexpr (!ALIGN_EPI) { if (wr == 0) PG8_BAR; }
    PG8_BAR;
    if constexpr (Epi::AFTER_DRAIN) { E.fused(acc, cur, wr, wc, fr, fq, lds, wid, lane); S.done(cur); }
#undef PG8_SA
#undef PG8_SB
#undef PG8_STAGE
#undef PG8_LDA
#undef PG8_LDB
#undef PG8_MMA
#undef PG8_WAIT_V
#undef PG8_WAIT_L
#undef PG8_BAR
#undef PG8_SCHED
}
}

using pg8::bf16_t; using pg8::bf16x8; using pg8::f32x4; using pg8::u32x4; using pg8::Unit;
#define LAS __attribute__((address_space(3)))
typedef float f32x16 __attribute__((ext_vector_type(16)));
typedef short s16x4 __attribute__((ext_vector_type(4)));
typedef float f32x2_t __attribute__((ext_vector_type(2)));
typedef __bf16 bf16x2_t __attribute__((ext_vector_type(2)));
typedef unsigned u32x2 __attribute__((ext_vector_type(2)));
typedef short v4i16_t __attribute__((ext_vector_type(4)));

#define DI __device__ __forceinline__
DI unsigned pk2(float lo, float hi) { f32x2_t v = {lo, hi}; bf16x2_t b = __builtin_convertvector(v, bf16x2_t); return __builtin_bit_cast(unsigned, b); }
DI float bflo(unsigned u) { return __uint_as_float(u << 16); }
DI float bfhi(unsigned u) { return __uint_as_float(u & 0xffff0000u); }
DI float wave_sum(float v) {
#pragma unroll
    for (int o = 1; o < 64; o <<= 1) v += __shfl_xor(v, o);
    return v;
}
DI float sigmoidf_(float v) { return __builtin_amdgcn_rcpf(1.f + __builtin_amdgcn_exp2f(-1.4426950408889634f * v)); }
#define MFMA32(a, b, c) __builtin_amdgcn_mfma_f32_32x32x16_bf16((a), (b), (c), 0, 0, 0)
DI s16x4 vtr(const LAS unsigned char* p) { return __builtin_bit_cast(s16x4, __builtin_amdgcn_ds_read_tr16_b64_v4i16((LAS v4i16_t*)p)); }

constexpr int M = 16384, D = 1024, NIN = 6656, FF = 2816, MP = 8192;
constexpr float EPS = 1e-6f;
constexpr float C2 = 0.125f * 1.4426950408889634f;
constexpr float LOG2E = 1.4426950408889634f;
constexpr size_t MiB = 1u << 20;
constexpr size_t WS_MOD = 0, WS_ROPE = 128 * 1024, WS_LAM = 256 * 1024, WS_GAIN = 260 * 1024, WS_BAR = 512 * 1024;
constexpr size_t WS_WIN = 1 * MiB, WS_WOA = 14 * MiB, WS_WOB = 16 * MiB, WS_WOUT = 18 * MiB, WS_WGU = 20 * MiB, WS_WDN = 31 * MiB;
constexpr size_t WS_H = 37 * MiB, WS_QA = 69 * MiB, WS_QB = 101 * MiB, WS_KA = 133 * MiB, WS_VA = 169 * MiB, WS_KB = 205 * MiB, WS_VB = 214 * MiB;
constexpr size_t WS_T1 = WS_KA, WS_ACT = WS_KA, WS_END = 223 * MiB;
constexpr int LDS_BYTES = 147456;
constexpr size_t O_YS = 0, O_DK = 16777216, O_DV = 25165824, O_WK = 33554432, O_WV = 35651584;

struct Params {
    const float *x_prompt, *x_sample, *cdk, *cdv, *cwk, *cwv, *c, *c_ctx, *w_ada, *b_ada, *norm1_g, *w_in, *qn_a, *kn_a, *lq1, *lk1, *lq2, *lk2,
        *subln_g, *qn_b, *kn_b, *sink, *w_oa, *w_ob, *w_out, *norm2_g, *w_gate, *w_up, *w_down;
    float* out; unsigned char* ws;
};

DI void p0_mod_task(const Params& p, int task, LAS unsigned char* lds, int tid) {
    float* mod = (float*)(p.ws + WS_MOD);
    if (task < 192) {
        LAS float* s = (LAS float*)lds;
        LAS float* red = (LAS float*)(lds + 20480);
        for (int i = tid; i < 5 * 1024; i += 512) { const int r = i >> 10, k = i & 1023; const float v = r == 0 ? p.c_ctx[k] : p.c[(r - 1) * 1024 + k]; s[i] = v / (1.f + expf(-v)); }
        __syncthreads();
        const int ks = tid >> 5, col = tid & 31; const float* w = p.w_ada + task * 32 + col;
        float a0 = 0.f, a1 = 0.f, a2 = 0.f, a3 = 0.f, a4 = 0.f;
#pragma unroll 8
        for (int i = 0; i < 64; ++i) { const int k = ks + 16 * i; const float wv = w[(size_t)k * 6144];
            a0 += s[k] * wv; a1 += s[1024 + k] * wv; a2 += s[2048 + k] * wv; a3 += s[3072 + k] * wv; a4 += s[4096 + k] * wv; }
        red[(ks * 5 + 0) * 32 + col] = a0; red[(ks * 5 + 1) * 32 + col] = a1; red[(ks * 5 + 2) * 32 + col] = a2; red[(ks * 5 + 3) * 32 + col] = a3; red[(ks * 5 + 4) * 32 + col] = a4;
        __syncthreads();
        if (tid < 160) { const int r = tid >> 5, cc = tid & 31; float t = 0.f;
#pragma unroll
            for (int j = 0; j < 16; ++j) t += red[(j * 5 + r) * 32 + cc];
            mod[r * 6144 + task * 32 + cc] = t + p.b_ada[task * 32 + cc]; }
        __syncthreads();
    } else {
        float* tab = (float*)(p.ws + WS_ROPE);
        for (int i = tid; i < 1024; i += 512) { const int pos = i >> 4, j = i & 15; const float freq = powf(10000.f, -(float)j / 16.f); const float ang = (float)pos * freq; tab[i] = cosf(ang); tab[1024 + i] = sinf(ang); }
        if (tid < 256) { const int ty = tid >> 6, j = tid & 63; float* gt = (float*)(p.ws + WS_GAIN);
            gt[tid] = ty == 0 ? p.qn_a[j] * C2 : ty == 1 ? p.kn_a[j] : ty == 2 ? p.qn_b[j] * C2 : p.kn_b[j]; }
        if (tid < 64) { float a = p.lq1[tid] * p.lk1[tid], b = p.lq2[tid] * p.lk2[tid]; a = wave_sum(a); b = wave_sum(b); if (tid == 0) *(float*)(p.ws + WS_LAM) = expf(a) - expf(b) + 0.2f; }
    }
}
DI int wrow_map(int mode, int n) {
    if (mode == 1) { const int L = n & 255; return (n & ~255) + 128 * ((L >> 4) & 1) + 32 * (L >> 6) + 8 * ((L >> 2) & 3) + 4 * ((L >> 5) & 1) + (L & 3); }
    if (mode == 5) { const int L = n & 31; return (n & ~31) + 8 * ((L >> 2) & 3) + 4 * ((L >> 4) & 1) + (L & 3); }
    if (mode == 2) return 256 * (n >> 7) + (n & 127);
    if (mode == 3) return 256 * (n >> 7) + 128 + (n & 127);
    return n;
}
DI void transpose_item(const float* W, int K, int N, bf16_t* WT, int mode, LAS float* scr, int item, int lane) {
    const int nblk = N / 32, kb = item / nblk, nb = item % nblk, k0 = 64 * kb, n0 = 32 * nb;
    if (mode < 0) mode = (n0 < 2048 || (n0 >= 3072 && n0 < 4352)) ? 1 : 0;
#pragma unroll 8
    for (int i = 0; i < 32; ++i) { const int kk = 2 * i + (lane >> 5); scr[kk * 33 + (lane & 31)] = W[(size_t)(k0 + kk) * N + n0 + (lane & 31)]; }
    asm volatile("s_waitcnt lgkmcnt(0)" ::: "memory");
    const int c = lane & 7;
#pragma unroll
    for (int j = 0; j < 4; ++j) { const int n = (lane >> 3) + 8 * j; const LAS float* s = scr + (8 * c) * 33 + n;
        u32x4 o; o.x = pk2(s[0 * 33], s[1 * 33]); o.y = pk2(s[2 * 33], s[3 * 33]); o.z = pk2(s[4 * 33], s[5 * 33]); o.w = pk2(s[6 * 33], s[7 * 33]);
        *(u32x4*)(WT + (size_t)wrow_map(mode, n0 + n) * K + k0 + 8 * c) = o; }
    asm volatile("s_waitcnt lgkmcnt(0)" ::: "memory");
}
DI void convert_span(const float* src, bf16_t* dst, int n4, int gtid, int nthr) {
    for (int i = gtid; i < n4; i += nthr) { const f32x4 v = ((const f32x4*)src)[i]; u32x2 o; o.x = pk2(v.x, v.y); o.y = pk2(v.z, v.w); ((u32x2*)dst)[i] = o; }
}
DI void convert_span_perm(const float* src, bf16_t* dst, int n4, int gtid, int nthr) {
    for (int i = gtid; i < n4; i += nthr) { const f32x4 v = ((const f32x4*)src)[i]; u32x2 o; o.x = pk2(v.x, v.y); o.y = pk2(v.z, v.w);
        const int e0 = 4 * i, d0 = e0 & 63, pp = 32 * ((d0 >> 4) & 1) + 8 * ((d0 >> 2) & 3) + 4 * ((d0 >> 5) & 1);
        *(u32x2*)(dst + (e0 - d0) + pp) = o; }
}
DI void norm_rows(const float* xa, const float* xb, const float* gain, const float* mod, int sh_off, int sc_off, bf16_t* out, int gw, int ngw, int lane) {
    for (int m = gw; m < M; m += ngw) {
        const float* xr = m < MP ? xa + (size_t)m * D : xb + (size_t)(m - MP) * D;
        const float* md = mod + (m < MP ? 0 : 1 + ((m - MP) >> 11)) * 6144;
        f32x4 v[4]; float ss = 0.f;
#pragma unroll
        for (int j = 0; j < 4; ++j) { v[j] = *(const f32x4*)(xr + 4 * lane + 256 * j); ss += (v[j].x * v[j].x + v[j].y * v[j].y) + (v[j].z * v[j].z + v[j].w * v[j].w); }
        const float rstd = rsqrtf(wave_sum(ss) * (1.f / D) + EPS);
#pragma unroll
        for (int j = 0; j < 4; ++j) { const int col = 4 * lane + 256 * j;
            const f32x4 g = *(const f32x4*)(gain + col), sc = *(const f32x4*)(md + sc_off + col), sh = *(const f32x4*)(md + sh_off + col);
            const f32x4 y = v[j] * rstd * g * (sc + 1.0f) + sh;
            u32x2 o; o.x = pk2(y.x, y.y); o.y = pk2(y.z, y.w); *(u32x2*)(out + (size_t)m * D + col) = o; }
    }
}

struct EpiIn {
    static constexpr bool PERM = true, AFTER_DRAIN = false;
    unsigned char* ws; float* out;
    DI void operator()(const f32x4 (&acc)[2][2][4][2], const Unit& u, int wr, int wc, int fr, int fq) const {
        asm volatile("" : "+v"(fr), "+v"(fq));
        const int pn = u.pn, pm = u.pm; const bool prompt = pm < 32;
        bf16_t *QA = (bf16_t*)(ws + WS_QA), *KA = (bf16_t*)(ws + WS_KA), *VA = (bf16_t*)(ws + WS_VA), *QB = (bf16_t*)(ws + WS_QB), *KB = (bf16_t*)(ws + WS_KB), *VB = (bf16_t*)(ws + WS_VB), *G = (bf16_t*)out;
        float *o_dk = out + O_DK, *o_dv = out + O_DV, *o_wk = out + O_WK, *o_wv = out + O_WV;
        const float* rope = (const float*)(ws + WS_ROPE); const float* gains = (const float*)(ws + WS_GAIN);
        int kvrow0, t0;
        if (prompt) { kvrow0 = pm * 256; t0 = 0; } else { const int sm = pm - 32; t0 = (sm & 7) * 256; kvrow0 = MP + (sm >> 3) * 2560 + t0; }
        const size_t m0 = (size_t)pm * 256;
        if (pn < 8 || (pn >= 12 && pn < 17)) {
            const float* gain; bf16_t* dst; int dstS; float* fo = nullptr; int foS = 0;
            if (pn < 4) { gain = gains; dst = QA + m0 * 1024 + pn * 256; dstS = 1024; }
            else if (pn < 8) { gain = gains + 64; dst = KA + (size_t)kvrow0 * 1024 + (pn - 4) * 256; dstS = 1024; if (prompt) { fo = o_dk + m0 * 1024 + (pn - 4) * 256; foS = 1024; } }
            else if (pn < 16) { gain = gains + 128; dst = QB + m0 * 1024 + (pn - 12) * 256; dstS = 1024; }
            else { gain = gains + 192; dst = KB + (size_t)kvrow0 * 256; dstS = 256; if (prompt) { fo = o_wk + m0 * 256; foS = 256; } }
            f32x4 gv[2][2];
#pragma unroll
            for (int bj = 0; bj < 2; ++bj)
#pragma unroll
                for (int n = 0; n < 2; ++n) gv[bj][n] = *(const f32x4*)(gain + 32 * n + 16 * bj + 4 * fq);
            float rstd8[8];
#pragma unroll
            for (int ai = 0; ai < 2; ++ai)
#pragma unroll
                for (int m = 0; m < 4; ++m) { float ss = 0.f;
#pragma unroll
                    for (int bj = 0; bj < 2; ++bj)
#pragma unroll
                        for (int n = 0; n < 2; ++n) { const f32x4 t = acc[ai][bj][m][n]; ss += (t.x * t.x + t.y * t.y) + (t.z * t.z + t.w * t.w); }
                    rstd8[ai * 4 + m] = ss; }
#pragma unroll
            for (int j = 0; j < 8; ++j) rstd8[j] += __shfl_xor(rstd8[j], 16);
#pragma unroll
            for (int j = 0; j < 8; ++j) rstd8[j] += __shfl_xor(rstd8[j], 32);
#pragma unroll
            for (int j = 0; j < 8; ++j) rstd8[j] = rsqrtf(rstd8[j] * (1.f / 64.f) + EPS);
            asm volatile("" ::: "memory"); __builtin_amdgcn_sched_barrier(0);
#pragma unroll
            for (int ai = 0; ai < 2; ++ai)
#pragma unroll
                for (int m = 0; m < 4; ++m) {
                    const int row = 128 * ai + 64 * wr + 16 * m + fr;
                    f32x4 y[2][2];
#pragma unroll
                    for (int bj = 0; bj < 2; ++bj)
#pragma unroll
                        for (int n = 0; n < 2; ++n) y[bj][n] = acc[ai][bj][m][n];
                    const float rstd = rstd8[ai * 4 + m];
#pragma unroll
                    for (int bj = 0; bj < 2; ++bj)
#pragma unroll
                        for (int n = 0; n < 2; ++n) y[bj][n] = y[bj][n] * rstd * gv[bj][n];
                    if (!prompt) {
                        const int t = t0 + row, grow = t >> 6, gcol = t & 63;
#pragma unroll
                        for (int n = 0; n < 2; ++n) { const int pos = n == 0 ? grow : gcol;
                            const f32x4 cs = *(const f32x4*)(rope + pos * 16 + 4 * fq), sn = *(const f32x4*)(rope + 1024 + pos * 16 + 4 * fq);
                            const f32x4 x1 = y[0][n], x2 = y[1][n];
                            y[0][n] = x1 * cs - x2 * sn; y[1][n] = x2 * cs + x1 * sn; }
                    }
#pragma unroll
                    for (int bj = 0; bj < 2; ++bj) { u32x4 o; o.x = pk2(y[bj][0].x, y[bj][0].y); o.y = pk2(y[bj][0].z, y[bj][0].w); o.z = pk2(y[bj][1].x, y[bj][1].y); o.w = pk2(y[bj][1].z, y[bj][1].w);
                        *(u32x4*)(dst + (size_t)row * dstS + 64 * wc + 32 * bj + 8 * fq) = o; }
                    if (fo) {
#pragma unroll
                        for (int bj = 0; bj < 2; ++bj)
#pragma unroll
                            for (int n = 0; n < 2; ++n) *(f32x4*)(fo + (size_t)row * foS + 64 * wc + 32 * n + 16 * bj + 4 * fq) = y[bj][n]; }
                    asm volatile("" ::: "memory"); __builtin_amdgcn_sched_barrier(0);
                }
        } else if (pn < 12 || pn == 17) {
            bf16_t* dst; int dstS; float* fo = nullptr;
            if (pn < 12) { dst = VA + (size_t)kvrow0 * 1024 + (pn - 8) * 256; dstS = 1024; if (prompt) fo = o_dv + m0 * 1024 + (pn - 8) * 256; }
            else { dst = VB + (size_t)kvrow0 * 256; dstS = 256; if (prompt) fo = o_wv + m0 * 256; }
#pragma unroll
            for (int ai = 0; ai < 2; ++ai)
#pragma unroll
                for (int m = 0; m < 4; ++m) { const int row = 128 * ai + 64 * wr + 16 * m + fr;
#pragma unroll
                    for (int bj = 0; bj < 2; ++bj) { const int col = 128 * bj + 32 * wc + 8 * fq; const f32x4 v0 = acc[ai][bj][m][0], v1 = acc[ai][bj][m][1];
                        u32x4 o; o.x = pk2(v0.x, v0.y); o.y = pk2(v0.z, v0.w); o.z = pk2(v1.x, v1.y); o.w = pk2(v1.z, v1.w);
                        *(u32x4*)(dst + (size_t)row * dstS + col) = o;
                        if (fo) { *(f32x4*)(fo + (size_t)row * dstS + col) = v0; *(f32x4*)(fo + (size_t)row * dstS + col + 4) = v1; } } }
        } else {
            bf16_t* dst = G + m0 * 2048 + (pn - 18) * 256;
#pragma unroll
            for (int ai = 0; ai < 2; ++ai)
#pragma unroll
                for (int m = 0; m < 4; ++m) { const int row = 128 * ai + 64 * wr + 16 * m + fr;
#pragma unroll
                    for (int bj = 0; bj < 2; ++bj) { const int col = 128 * bj + 32 * wc + 8 * fq; const f32x4 v0 = acc[ai][bj][m][0], v1 = acc[ai][bj][m][1];
                        u32x4 o; o.x = pk2(sigmoidf_(v0.x), sigmoidf_(v0.y)); o.y = pk2(sigmoidf_(v0.z), sigmoidf_(v0.w)); o.z = pk2(sigmoidf_(v1.x), sigmoidf_(v1.y)); o.w = pk2(sigmoidf_(v1.z), sigmoidf_(v1.w));
                        *(u32x4*)(dst + (size_t)row * 2048 + col) = o; } }
        }
    }
};
template <int MODE> struct EpiC8 {
    static constexpr bool PERM = true, AFTER_DRAIN = false;
    const bf16_t* G; float* T1; bf16_t* OB; const float* xp; const float* xs; const float* mod; float* X1;
    DI void operator()(const f32x4 (&acc)[2][2][4][2], const Unit& u, int wr, int wc, int fr, int fq) const {
        asm volatile("" : "+v"(fr), "+v"(fq));
        const int pn = u.pn, pm = u.pm; const size_t m0 = (size_t)pm * 256;
        const float* md = mod + (pm < 32 ? 0 : 1 + ((pm - 32) >> 3)) * 6144;
#pragma unroll
        for (int ai = 0; ai < 2; ++ai)
#pragma unroll
            for (int m = 0; m < 4; ++m) { const size_t row = m0 + 128 * ai + 64 * wr + 16 * m + fr;
                if (MODE == 4) { const int col = 128 * pn + 32 * wc + 8 * fq;
                    const f32x4 g0 = acc[ai][0][m][0], g1 = acc[ai][0][m][1], u0 = acc[ai][1][m][0], u1 = acc[ai][1][m][1];
                    u32x4 o; o.x = pk2(g0.x * sigmoidf_(g0.x) * u0.x, g0.y * sigmoidf_(g0.y) * u0.y); o.y = pk2(g0.z * sigmoidf_(g0.z) * u0.z, g0.w * sigmoidf_(g0.w) * u0.w);
                    o.z = pk2(g1.x * sigmoidf_(g1.x) * u1.x, g1.y * sigmoidf_(g1.y) * u1.y); o.w = pk2(g1.z * sigmoidf_(g1.z) * u1.z, g1.w * sigmoidf_(g1.w) * u1.w);
                    *(u32x4*)(OB + row * FF + col) = o;
                } else {
#pragma unroll
                    for (int bj = 0; bj < 2; ++bj) { const int col = 256 * pn + 128 * bj + 32 * wc + 8 * fq; const f32x4 v0 = acc[ai][bj][m][0], v1 = acc[ai][bj][m][1];
                        if (MODE == 0 || MODE == 1) {
                            const u32x4 gq = *(const u32x4*)(G + row * 2048 + (MODE == 1 ? 1024 : 0) + col);
                            const f32x4 ga = {bflo(gq.x), bfhi(gq.x), bflo(gq.y), bfhi(gq.y)}, gb = {bflo(gq.z), bfhi(gq.z), bflo(gq.w), bfhi(gq.w)};
                            bf16_t* T1b = (bf16_t*)T1;
                            if (MODE == 0) { const f32x4 t0 = ga * v0, t1 = gb * v1; u32x4 o; o.x = pk2(t0.x, t0.y); o.y = pk2(t0.z, t0.w); o.z = pk2(t1.x, t1.y); o.w = pk2(t1.z, t1.w); *(u32x4*)(T1b + row * D + col) = o; }
                            else { const u32x4 tq = *(const u32x4*)(T1b + row * D + col);
                                const f32x4 r0 = (f32x4){bflo(tq.x), bfhi(tq.x), bflo(tq.y), bfhi(tq.y)} + ga * v0, r1 = (f32x4){bflo(tq.z), bfhi(tq.z), bflo(tq.w), bfhi(tq.w)} + gb * v1;
                                u32x4 o; o.x = pk2(r0.x, r0.y); o.y = pk2(r0.z, r0.w); o.z = pk2(r1.x, r1.y); o.w = pk2(r1.z, r1.w); *(u32x4*)(OB + row * D + col) = o; }
                        } else if (MODE == 2) {
                            const int c0 = 256 * pn + 128 * bj + 32 * wc + 4 * fq;
                            const float* xr = row < MP ? xp + row * D : xs + (row - MP) * D;
                            const f32x4 g0 = *(const f32x4*)(md + 2048 + c0), g1 = *(const f32x4*)(md + 2048 + c0 + 16);
                            *(f32x4*)(X1 + row * D + c0) = *(const f32x4*)(xr + c0) + g0 * v0; *(f32x4*)(X1 + row * D + c0 + 16) = *(const f32x4*)(xr + c0 + 16) + g1 * v1;
                        } else {
                            const int c0 = 256 * pn + 128 * bj + 32 * wc + 4 * fq;
                            const f32x4 g0 = *(const f32x4*)(md + 5120 + c0), g1 = *(const f32x4*)(md + 5120 + c0 + 16);
                            float* xo = X1 + row * D + c0;
                            const f32x4 a0 = *(const f32x4*)xo, a1 = *(const f32x4*)(xo + 16);
                            *(f32x4*)xo = a0 + g0 * v0; *(f32x4*)(xo + 16) = a1 + g1 * v1;
                        } } } }
    }
};

DI float max3_(float a, float b, float c) { float r; asm("v_max3_f32 %0, %1, %2, %3" : "=v"(r) : "v"(a), "v"(b), "v"(c)); return r; }
template <int MODE>
DI void attn_unit(LAS unsigned char* lds, const bf16_t* Qw, bf16_t* Ow, const bf16_t* Kt, const bf16_t* Vt, int ra0, int ra1, int rb0, int rb1,
                  int qpos0, bool band, float sink_l2, float lam, const float* subg, int tid, int wave) {
    constexpr int KW = MODE == 0 ? 128 : 64, DV = KW, KS = MODE == 0 ? 1024 : 256;
    constexpr int KRS = KW * 2 + 16, VRS = DV * 2 + 64, KBYTES = 64 * KRS, VBYTES = 64 * VRS, VOFF = 2 * KBYTES;
    constexpr int CH = KW / 8, NL = 64 * CH / 512, NDV = DV / 32;
    constexpr float THR = 8.f;
    const int lane = tid & 63, h = lane >> 5, r = lane & 31;
    const int kc = MODE == 0 ? 64 * (wave >> 2) : 0;
    const int grp = wave >> 2;
    bf16x8 qf[4];
#pragma unroll
    for (int s = 0; s < 4; ++s) qf[s] = *(const bf16x8*)(Qw + (size_t)r * 1024 + 16 * s + 8 * h);
    f32x16 o[NDV], zero16, negm;
#pragma unroll
    for (int i = 0; i < 16; ++i) { zero16[i] = 0.f; negm[i] = 0.f; }
#pragma unroll
    for (int d = 0; d < NDV; ++d) o[d] = zero16;
    float mref = 0.f, lrun = 0.f; bool started = false, pact = false;
    bf16x8 pf[2][2];
#pragma unroll
    for (int a = 0; a < 2; ++a)
#pragma unroll
        for (int b = 0; b < 2; ++b) pf[a][b] = (bf16x8){0, 0, 0, 0, 0, 0, 0, 0};
    const int na = ra1 - ra0, nt = na + (rb1 - rb0);
    u32x4 kreg[NL], vreg[NL];
    const int q4 = (lane & 15) >> 2, p4 = lane & 3, blk = (lane >> 4) & 1;
    const unsigned goff = (unsigned)((tid / CH) * KS + (tid % CH) * 8) * 2u;
    const unsigned lks = (unsigned)((tid / CH) * KRS + (tid % CH) * 16), lvs = (unsigned)((tid / CH) * VRS + (tid % CH) * 16);
#define AT_KEY0(it) ((((it) < na) ? (ra0 + (it)) : (rb0 + (it) - na)) * 64)
#define AT_ACTIVE(key0_) (!((MODE == 1) && band && (key0_) < 2048) || (((key0_) + 63 >= qpos0 - 128) && ((key0_) <= qpos0 + 159)))
#define AT_GLOAD(it) do { const int key0_ = AT_KEY0(it); const char* kb_ = (const char*)(Kt + (size_t)key0_ * KS); const char* vb_ = (const char*)(Vt + (size_t)key0_ * KS); \
        _Pragma("unroll") for (int i_ = 0; i_ < NL; ++i_) { kreg[i_] = *(const u32x4*)(kb_ + (size_t)i_ * (512 / CH) * KS * 2 + goff); vreg[i_] = *(const u32x4*)(vb_ + (size_t)i_ * (512 / CH) * KS * 2 + goff); } } while (0)
#define AT_LSTORE(kb, vb) do { _Pragma("unroll") for (int i_ = 0; i_ < NL; ++i_) { \
        *(LAS u32x4*)(lds + (kb) * KBYTES + i_ * (512 / CH) * KRS + lks) = kreg[i_]; *(LAS u32x4*)(lds + VOFF + (vb) * VBYTES + i_ * (512 / CH) * VRS + lvs) = vreg[i_]; } } while (0)
#define AT_VREADK(F, ks) do { _Pragma("unroll") for (int d_ = 0; d_ < NDV; ++d_) { const LAS unsigned char* a_ = vbase + (16 * (ks)) * VRS + 64 * d_; \
        const s16x4 lo_ = vtr(a_), hi_ = vtr(a_ + 8 * VRS); F[d_] = __builtin_shufflevector(lo_, hi_, 0, 1, 2, 3, 4, 5, 6, 7); } } while (0)
#define AT_PVK(F, ks) do { __builtin_amdgcn_s_setprio(1); _Pragma("unroll") for (int d_ = 0; d_ < NDV; ++d_) o[d_] = MFMA32(F[d_], pf[(ks) >> 1][(ks) & 1], o[d_]); __builtin_amdgcn_s_setprio(0); } while (0)
#define AT_Y(VS) do { if (pact) { \
        const LAS unsigned char* vbase = lds + VOFF + (VS) * VBYTES + (4 * h + q4) * VRS + 32 * blk + 8 * p4; \
        bf16x8 vfa[NDV], vfb[NDV]; \
        AT_VREADK(vfa, 0); AT_VREADK(vfb, 1); __builtin_amdgcn_sched_barrier(0); \
        AT_PVK(vfa, 0); __builtin_amdgcn_sched_barrier(0); \
        AT_VREADK(vfa, 2); __builtin_amdgcn_sched_barrier(0); \
        AT_PVK(vfb, 1); __builtin_amdgcn_sched_barrier(0); \
        AT_VREADK(vfb, 3); __builtin_amdgcn_sched_barrier(0); \
        AT_PVK(vfa, 2); __builtin_amdgcn_sched_barrier(0); \
        AT_PVK(vfb, 3); __builtin_amdgcn_sched_barrier(0); \
        } } while (0)
    AT_GLOAD(0); AT_LSTORE(0, 0);
    __syncthreads();
    int vcur = 0, vprev = 2;
    for (int it = 0; it <= nt; ++it) {
        { const int tn_ = it + 1 < nt ? it + 1 : nt - 1; AT_GLOAD(tn_); }
        if (grp == 1) AT_Y(vprev);
        if (it < nt) {
            const int key0 = AT_KEY0(it);
            pact = AT_ACTIVE(key0);
            if (pact) {
                const LAS unsigned char* kl_ = lds + (it & 1) * KBYTES + r * KRS + (kc + 8 * h) * 2;
                bf16x8 kf0[4], kf1[4];
#pragma unroll
                for (int sd = 0; sd < 4; ++sd) { kf0[sd] = *(const LAS bf16x8*)(kl_ + 32 * sd); kf1[sd] = *(const LAS bf16x8*)(kl_ + 32 * KRS + 32 * sd); }
                __builtin_amdgcn_sched_barrier(0);
                f32x16 C0 = negm, C1 = negm;
                __builtin_amdgcn_s_setprio(1);
#pragma unroll
                for (int sd = 0; sd < 4; ++sd) { C0 = MFMA32(kf0[sd], qf[sd], C0); C1 = MFMA32(kf1[sd], qf[sd], C1); }
                __builtin_amdgcn_s_setprio(0);
                __builtin_amdgcn_sched_barrier(0);
                if ((MODE == 1) && band && key0 < 2048) { const int dq = key0 + 4 * h - (qpos0 + r);
#pragma unroll
                    for (int i = 0; i < 16; ++i) { const int d0 = dq + (i & 3) + 8 * (i >> 2), d1 = d0 + 32;
                        if (d0 < -128 || d0 > 128) C0[i] = -1e30f;
                        if (d1 < -128 || d1 > 128) C1[i] = -1e30f; } }
                float mx = max3_(C0[0], C1[0], C0[1]);
#pragma unroll
                for (int i = 1; i < 15; ++i) mx = max3_(mx, C1[i], C0[i + 1]);
                mx = fmaxf(mx, C1[15]);
                mx = fmaxf(mx, __shfl_xor(mx, 32));
                if (!started || __any(mx > THR)) {
                    const float dd = started ? fmaxf(mx, 0.f) : fmaxf(mx, -1e4f);
                    mref += dd;
#pragma unroll
                    for (int i = 0; i < 16; ++i) { C0[i] -= dd; C1[i] -= dd; negm[i] -= dd; }
                    if (started) { const float alpha = __builtin_amdgcn_exp2f(-dd); lrun *= alpha;
#pragma unroll
                        for (int d = 0; d < NDV; ++d) o[d] = o[d] * alpha; }
                    started = true;
                }
                float sum = 0.f;
#pragma unroll
                for (int i = 0; i < 16; ++i) { C0[i] = __builtin_amdgcn_exp2f(C0[i]); C1[i] = __builtin_amdgcn_exp2f(C1[i]); sum += C0[i] + C1[i]; }
                lrun += sum;
#pragma unroll
                for (int s = 0; s < 2; ++s) { u32x4 a, b;
                    a.x = pk2(C0[8 * s + 0], C0[8 * s + 1]); a.y = pk2(C0[8 * s + 2], C0[8 * s + 3]); a.z = pk2(C0[8 * s + 4], C0[8 * s + 5]); a.w = pk2(C0[8 * s + 6], C0[8 * s + 7]);
                    b.x = pk2(C1[8 * s + 0], C1[8 * s + 1]); b.y = pk2(C1[8 * s + 2], C1[8 * s + 3]); b.z = pk2(C1[8 * s + 4], C1[8 * s + 5]); b.w = pk2(C1[8 * s + 6], C1[8 * s + 7]);
                    pf[0][s] = __builtin_bit_cast(bf16x8, a); pf[1][s] = __builtin_bit_cast(bf16x8, b); }
            }
            if (grp == 0) AT_Y(vcur);
        }
        { const int vn_ = vcur == 2 ? 0 : vcur + 1; AT_LSTORE((it + 1) & 1, vn_); vprev = vcur; vcur = vn_; }
        __syncthreads();
    }
#undef AT_KEY0
#undef AT_ACTIVE
#undef AT_GLOAD
#undef AT_LSTORE
#undef AT_VREADK
#undef AT_PVK
#undef AT_Y
    float ltot = lrun + __shfl_xor(lrun, 32);
    if (MODE == 1) ltot += __builtin_amdgcn_exp2f(sink_l2 - mref);
    const float inv = 1.f / ltot;
#pragma unroll
    for (int d = 0; d < NDV; ++d) o[d] = o[d] * inv;
    constexpr int ORS = DV * 2 + 16, LPR = DV / 8;
    LAS unsigned char* wimg = lds + wave * 16384;
    if (MODE == 1) {
#pragma unroll
        for (int d = 0; d < NDV; ++d)
#pragma unroll
            for (int g = 0; g < 4; ++g) { u32x2 w; w.x = pk2(o[d][4 * g], o[d][4 * g + 1]); w.y = pk2(o[d][4 * g + 2], o[d][4 * g + 3]);
                *(LAS u32x2*)(wimg + r * ORS + (32 * d + 8 * g + 4 * h) * 2) = w; }
        asm volatile("s_waitcnt lgkmcnt(0)" ::: "memory");
#pragma unroll
        for (int t = 0; t < 32 * LPR / 64; ++t) { const int row = (64 / LPR) * t + lane / LPR, ch = lane % LPR;
            const u32x4 v = *(const LAS u32x4*)(wimg + row * ORS + ch * 16); *(u32x4*)(Ow + (size_t)row * 1024 + ch * 8) = v; }
    } else {
        LAS float* ex = (LAS float*)lds;
        if (wave >= 4) {
#pragma unroll
            for (int d = 0; d < NDV; ++d)
#pragma unroll
                for (int i = 0; i < 16; ++i) ex[((wave - 4) * (NDV * 16) + d * 16 + i) * 64 + lane] = o[d][i];
        }
        __syncthreads();
        if (wave < 4) {
            float ss = 0.f;
#pragma unroll
            for (int d = 0; d < NDV; ++d)
#pragma unroll
                for (int i = 0; i < 16; ++i) { const float v = o[d][i] - lam * ex[(wave * (NDV * 16) + d * 16 + i) * 64 + lane]; o[d][i] = v; ss += v * v; }
            ss += __shfl_xor(ss, 32);
            const float rstd = rsqrtf(ss * (1.f / 128.f) + EPS) * 0.8f;
#pragma unroll
            for (int d = 0; d < NDV; ++d)
#pragma unroll
                for (int g = 0; g < 4; ++g) { const f32x4 gg = *(const f32x4*)(subg + 32 * d + 8 * g + 4 * h);
                    u32x2 w; w.x = pk2(o[d][4 * g] * rstd * gg.x, o[d][4 * g + 1] * rstd * gg.y); w.y = pk2(o[d][4 * g + 2] * rstd * gg.z, o[d][4 * g + 3] * rstd * gg.w);
                    *(LAS u32x2*)(wimg + r * ORS + (32 * d + 8 * g + 4 * h) * 2) = w; }
            asm volatile("s_waitcnt lgkmcnt(0)" ::: "memory");
#pragma unroll
            for (int t = 0; t < 32 * LPR / 64; ++t) { const int row = (64 / LPR) * t + lane / LPR, ch = lane % LPR;
                const u32x4 v = *(const LAS u32x4*)(wimg + row * ORS + ch * 16); *(u32x4*)(Ow + (size_t)row * 1024 + ch * 8) = v; }
        }
    }
}

#define XB_TMO      128
#define XB_XCNT(j)  (256  + 64 * (j))
#define XB_XSUB(j)  (1280 + 64 * (j))
#define XB_XGEN(j)  (2304 + 64 * (j))
#define XB_TOP      3328
#define XB_TOPGEN   3392
#define XCD_BAR_WORDS 3456
#define XB_SPIN_CAP (1u << 18)

__device__ __forceinline__ unsigned xb_ld(unsigned* p)              { return __hip_atomic_load(p, __ATOMIC_RELAXED, __HIP_MEMORY_SCOPE_AGENT); }
__device__ __forceinline__ unsigned xb_add(unsigned* p, unsigned v) { return __hip_atomic_fetch_add(p, v, __ATOMIC_RELAXED, __HIP_MEMORY_SCOPE_AGENT); }
__device__ __forceinline__ unsigned xb_xcc_id() { return (unsigned)__builtin_amdgcn_s_getreg((3 << 11) | 20) & 0xFu; }
#define XB_SPIN(cond, bar) do { unsigned _sp = 0; while (cond) { __builtin_amdgcn_s_sleep(1); \
    if ((++_sp & 255u) == 0u) { if (xb_ld(&(bar)[XB_TMO])) break; if (_sp > XB_SPIN_CAP) { atomicAdd(&(bar)[XB_TMO], 1u); break; } } } } while (0)

struct XcdBarrier {
    unsigned* bar; unsigned x;
    volatile LAS unsigned* st;
};

__device__ __forceinline__ XcdBarrier xcd_barrier_post(unsigned* bar, volatile LAS unsigned* st) {
    XcdBarrier b; b.bar = bar; b.x = xb_xcc_id(); b.st = st;
    if (threadIdx.x == 0) (void)xb_add(&bar[XB_XCNT(b.x)], 1u);
    return b;
}
__device__ __forceinline__ void xcd_barrier_complete(unsigned* bar, unsigned x, unsigned& nloc, unsigned& nx) {
    const unsigned G = gridDim.x * gridDim.y * gridDim.z;
    unsigned sum, cnt, mine, sp = 0u;
    for (;;) {
        sum = 0u; cnt = 0u; mine = 0u;
#pragma unroll
        for (unsigned j = 0; j < 16; ++j) { const unsigned c = xb_ld(&bar[XB_XCNT(j)]); sum += c; cnt += (c > 0u) ? 1u : 0u; mine = (j == x) ? c : mine; }
        if (sum == G) break;
        __builtin_amdgcn_s_sleep(1);
        if ((++sp & 255u) == 0u) { if (xb_ld(&bar[XB_TMO])) break; if (sp > XB_SPIN_CAP) { atomicAdd(&bar[XB_TMO], 1u); break; } }
    }
    nloc = mine > 0u ? mine : 1u; nx = cnt > 0u ? cnt : 1u;
}

__device__ __forceinline__ void xcd_barrier(const XcdBarrier& b) {
    asm volatile("s_waitcnt vmcnt(0)" ::: "memory");
    __syncthreads();
    if (threadIdx.x == 0) {
        unsigned* bar = b.bar;
        __builtin_amdgcn_s_waitcnt(0);
        unsigned nloc = b.st[0], nx = b.st[1];
        if (nloc == 0u) { xcd_barrier_complete(bar, b.x, nloc, nx); b.st[0] = nloc; b.st[1] = nx; }
        const unsigned old = xb_add(&bar[XB_XSUB(b.x)], 1u);
        const unsigned gen = old / nloc;
        if (old + 1u == (gen + 1u) * nloc) {
            __builtin_amdgcn_fence(__ATOMIC_RELEASE, "agent");
            asm volatile("s_waitcnt vmcnt(0)" ::: "memory");
            const unsigned og = xb_add(&bar[XB_TOP], 1u);
            const unsigned tg = og / nx;
            if (og + 1u == (tg + 1u) * nx) xb_add(&bar[XB_TOPGEN], 1u);
            else XB_SPIN(xb_ld(&bar[XB_TOPGEN]) == tg, bar);
            __builtin_amdgcn_fence(__ATOMIC_ACQUIRE, "agent");
            xb_add(&bar[XB_XGEN(b.x)], 1u);
            asm volatile("s_waitcnt vmcnt(0)" ::: "memory");
        } else {
            XB_SPIN(xb_ld(&bar[XB_XGEN(b.x)]) == gen, bar);
            __builtin_amdgcn_fence(__ATOMIC_ACQUIRE, "agent");
            asm volatile("s_waitcnt vmcnt(0)" ::: "memory");
        }
    }
    __syncthreads();
}

__global__ void __launch_bounds__(512, 2) fwd_kernel(Params p) {
    extern __shared__ __attribute__((aligned(16))) unsigned char lds_raw[];
    LAS unsigned char* lds = (LAS unsigned char*)lds_raw;
    cg::grid_group grid = cg::this_grid();
    const int tid = threadIdx.x, lane = tid & 63, wave = __builtin_amdgcn_readfirstlane(tid >> 6);
    const int G = gridDim.x, bx = blockIdx.x;
    const int gw = bx * 8 + wave, ngw = G * 8, gtid = bx * 512 + tid, nthr = G * 512;
    unsigned char* ws = p.ws;
    float* mod = (float*)(ws + WS_MOD); const float* rope = (const float*)(ws + WS_ROPE);
    bf16_t *WIN = (bf16_t*)(ws + WS_WIN), *WOA = (bf16_t*)(ws + WS_WOA), *WOB = (bf16_t*)(ws + WS_WOB), *WOUT = (bf16_t*)(ws + WS_WOUT), *WGU = (bf16_t*)(ws + WS_WGU), *WDN = (bf16_t*)(ws + WS_WDN);
    bf16_t *H = (bf16_t*)(ws + WS_H), *QA = (bf16_t*)(ws + WS_QA), *QB = (bf16_t*)(ws + WS_QB), *KA = (bf16_t*)(ws + WS_KA), *VA = (bf16_t*)(ws + WS_VA), *KB = (bf16_t*)(ws + WS_KB), *VB = (bf16_t*)(ws + WS_VB);
    float* T1 = (float*)(ws + WS_T1); bf16_t* ACT = (bf16_t*)(ws + WS_ACT);
    bf16_t* Gt = (bf16_t*)p.out;
    float* X1 = p.out;

    volatile LAS unsigned* bst = (volatile LAS unsigned*)(lds + 131072 + 64);
    if (tid < 2) bst[tid] = 0u;
    if (bx == 0) for (int i = tid; i < XCD_BAR_WORDS; i += 512) ((unsigned*)(ws + WS_BAR))[i] = 0u;
    grid.sync();
    const XcdBarrier xbar = xcd_barrier_post((unsigned*)(ws + WS_BAR), bst);
    for (int task = bx; task < 193; task += G) p0_mod_task(p, task, lds, tid);
    __syncthreads();
    {
        LAS float* scr = (LAS float*)(lds + wave * 16384);
        constexpr int I_IN = 16 * (NIN / 32), I_SQ = 16 * 32, I_FF = 16 * (FF / 32), I_DN = (FF / 64) * 32;
        constexpr int NITEMS = I_IN;
        for (int it0 = gw; it0 < NITEMS; it0 += ngw) transpose_item(p.w_in, D, NIN, WIN, -1, scr, it0, lane);
    }
    xcd_barrier(xbar);
    norm_rows(p.x_prompt, p.x_sample, p.norm1_g, mod, 0, 1024, H, gw, ngw, lane);
    xcd_barrier(xbar);
#ifndef SKIP_P2
    {
        pg8::Gemm g{H, WIN, M, NIN, D}; pg8::StaticOrder S; S.init(M, NIN, G, bx);
        EpiIn E{ws, p.out};
        pg8::gemm_phase<EpiIn, pg8::StaticOrder, true, true>(lds, g, S, E);
        const int nfull = (M / 256) * (NIN / 256) - (((M / 256) * (NIN / 256)) / G) * G;
        if (bx >= nfull) {
            __syncthreads();
            LAS float* scr = (LAS float*)(lds + wave * 16384);
            constexpr int I_FF = 16 * (FF / 32), I_DN = (FF / 64) * 32, I_SQ = 16 * 32;
            const int nidle = G - nfull;
            for (int it0 = (bx - nfull) * 8 + wave; it0 < 3 * I_SQ + 2 * I_FF; it0 += nidle * 8) {
                int it = it0;
                if (it < I_SQ) { transpose_item(p.w_oa, D, D, WOA, 0, scr, it, lane); continue; } it -= I_SQ;
                if (it < I_SQ) { transpose_item(p.w_ob, D, D, WOB, 0, scr, it, lane); continue; } it -= I_SQ;
                if (it < I_SQ) { transpose_item(p.w_out, D, D, WOUT, 5, scr, it, lane); continue; } it -= I_SQ;
                if (it < I_FF) { transpose_item(p.w_gate, D, FF, WGU, 2, scr, it, lane); continue; } it -= I_FF;
                transpose_item(p.w_up, D, FF, WGU, 3, scr, it - 0, lane);
            }
            const int itid = (bx - nfull) * 512 + tid, inthr = nidle * 512;
            for (int b = 0; b < 4; ++b) {
                const size_t kvr = (size_t)(MP + b * 2560 + 2048);
                convert_span_perm(p.cdk + (size_t)b * 512 * 1024, KA + kvr * 1024, 512 * 1024 / 4, itid, inthr);
                convert_span(p.cdv + (size_t)b * 512 * 1024, VA + kvr * 1024, 512 * 1024 / 4, itid, inthr);
                convert_span_perm(p.cwk + (size_t)b * 512 * 256, KB + kvr * 256, 512 * 256 / 4, itid, inthr);
                convert_span(p.cwv + (size_t)b * 512 * 256, VB + kvr * 256, 512 * 256 / 4, itid, inthr);
            }
        }
    }
#endif
    xcd_barrier(xbar);
#ifndef SKIP_P3
    {
        const float lam = *(const float*)(ws + WS_LAM);
        for (int u = bx; u < 2048; u += G) {
            const int kind = u >> 9, v = u & 511, rr = v >> 8, cc = v & 255, xcd = cc & 7, slot = cc >> 3;
            int tid = threadIdx.x; asm volatile("" : "+v"(tid));
            __syncthreads();
            if (kind == 0) {
                const int bh = rr * 16 + xcd * 2 + (slot >> 4), qblk = slot & 15, b = bh >> 3, hh = bh & 7;
                const size_t rows = (size_t)MP + b * 2048 + qblk * 128 + 32 * (wave & 3), kv0 = (size_t)MP + b * 2560;
                attn_unit<0>(lds, QA + rows * 1024 + hh * 128 + 64 * (wave >> 2), QA + rows * 1024 + hh * 128, KA + kv0 * 1024 + hh * 128, VA + kv0 * 1024 + hh * 128,
                             0, 40, 0, 0, 0, false, 0.f, lam, p.subln_g, tid, wave);
            } else if (kind == 1) {
                const int bg = rr * 8 + xcd, hin = slot >> 3, qblk = slot & 7, b = bg >> 2, g4 = bg & 3, hq = g4 * 4 + hin;
                const size_t rows = (size_t)MP + b * 2048 + qblk * 256 + 32 * wave, kv0 = (size_t)MP + b * 2560;
                const int lo = 4 * qblk - 2 < 0 ? 0 : 4 * qblk - 2, hi = 4 * qblk + 6 > 32 ? 32 : 4 * qblk + 6;
                attn_unit<1>(lds, QB + rows * 1024 + hq * 64, QB + rows * 1024 + hq * 64, KB + kv0 * 256 + g4 * 64, VB + kv0 * 256 + g4 * 64,
                             32, 40, lo, hi, qblk * 256 + 32 * wave, true, p.sink[hq] * LOG2E, lam, p.subln_g, tid, wave);
            } else if (kind == 2) {
                const int b = v >> 4, hh = (v >> 1) & 7, half = v & 1;
                const size_t rows = (size_t)b * 256 + half * 128 + 32 * (wave & 3), kv0 = (size_t)b * 256;
                attn_unit<0>(lds, QA + rows * 1024 + hh * 128 + 64 * (wave >> 2), QA + rows * 1024 + hh * 128, KA + kv0 * 1024 + hh * 128, VA + kv0 * 1024 + hh * 128,
                             0, 4, 0, 0, 0, false, 0.f, lam, p.subln_g, tid, wave);
            } else {
                const int b = v >> 4, hq = v & 15, g4 = hq >> 2;
                const size_t rows = (size_t)b * 256 + 32 * wave, kv0 = (size_t)b * 256;
                attn_unit<1>(lds, QB + rows * 1024 + hq * 64, QB + rows * 1024 + hq * 64, KB + kv0 * 256 + g4 * 64, VB + kv0 * 256 + g4 * 64,
                             0, 4, 0, 0, 0, false, p.sink[hq] * LOG2E, lam, p.subln_g, tid, wave);
            }
        }
    }
#endif
    xcd_barrier(xbar);
#ifndef SKIP_P4
    {
        pg8::StaticOrder S; S.init(M, D, G, bx);
        { pg8::Gemm g{QA, WOA, M, D, D}; EpiC8<0> E{Gt, T1, nullptr, nullptr, nullptr, mod, nullptr}; pg8::gemm_phase<EpiC8<0>, pg8::StaticOrder, true, true>(lds, g, S, E); }
        __syncthreads();
        { pg8::Gemm g{QB, WOB, M, D, D}; EpiC8<1> E{Gt, T1, H, nullptr, nullptr, mod, nullptr}; pg8::gemm_phase<EpiC8<1>, pg8::StaticOrder, true, true>(lds, g, S, E); }
    }
#endif
    xcd_barrier(xbar);
#ifndef SKIP_P5
    {
        pg8::Gemm g{H, WOUT, M, D, D}; pg8::StaticOrder S; S.init(M, D, G, bx);
        EpiC8<2> E{nullptr, nullptr, nullptr, p.x_prompt, p.x_sample, mod, X1};
        pg8::gemm_phase<EpiC8<2>, pg8::StaticOrder, true, true>(lds, g, S, E);
    }
#endif
    xcd_barrier(xbar);
    norm_rows(X1, X1 + (size_t)MP * D, p.norm2_g, mod, 3072, 4096, H, gw, ngw, lane);
    xcd_barrier(xbar);
#ifndef SKIP_P7
    {
        pg8::Gemm g{H, WGU, M, 2 * FF, D}; pg8::StaticOrder S; S.init(M, 2 * FF, G, bx);
        EpiC8<4> E{nullptr, nullptr, ACT, nullptr, nullptr, mod, nullptr};
        pg8::gemm_phase<EpiC8<4>, pg8::StaticOrder, true, true>(lds, g, S, E);
        const int nwg7 = (M / 256) * (2 * FF / 256), nfull7 = nwg7 - (nwg7 / G) * G;
        if (bx >= nfull7) {
            __syncthreads();
            LAS float* scr = (LAS float*)(lds + wave * 16384);
            constexpr int I_DN = (FF / 64) * 32;
            const int nidle = G - nfull7;
            for (int it0 = (bx - nfull7) * 8 + wave; it0 < I_DN; it0 += nidle * 8) transpose_item(p.w_down, FF, D, WDN, 5, scr, it0, lane);
        }
    }
#endif
    xcd_barrier(xbar);
#ifndef SKIP_P8
    {
        pg8::Gemm g{ACT, WDN, M, D, FF}; pg8::StaticOrder S; S.init(M, D, G, bx);
        EpiC8<3> E{nullptr, nullptr, nullptr, nullptr, nullptr, mod, X1};
        pg8::gemm_phase<EpiC8<3>, pg8::StaticOrder, true, true>(lds, g, S, E);
    }
#endif
}

extern "C" void kernel_launch(void* const* d_in, const int* in_sizes, int n_in, void* d_out, int out_size, void* d_ws, size_t ws_size, hipStream_t stream) {
    static int grid = 0;
    if (grid == 0) {
        if (n_in != 29 || ws_size < WS_END) { fprintf(stderr, "kernel_launch: unexpected n_in %d / ws %zu\n", n_in, ws_size); grid = -1; return; }
        int dev = 0, cus = 0, per_cu = 0;
        (void)hipGetDevice(&dev); (void)hipDeviceGetAttribute(&cus, hipDeviceAttributeMultiprocessorCount, dev);
        if (hipFuncSetAttribute((const void*)fwd_kernel, hipFuncAttributeMaxDynamicSharedMemorySize, LDS_BYTES) != hipSuccess) fprintf(stderr, "kernel_launch: hipFuncSetAttribute failed\n");
        if (hipOccupancyMaxActiveBlocksPerMultiprocessor(&per_cu, (const void*)fwd_kernel, 512, LDS_BYTES) != hipSuccess || per_cu < 1) { fprintf(stderr, "kernel_launch: occupancy query gave %d\n", per_cu); per_cu = 1; }
        (void)hipGetLastError();
        grid = cus > 0 ? cus : 256;
    }
    if (grid < 0) return;
    Params p{};
    const float** pp = (const float**)&p;
    for (int i = 0; i < 29; ++i) pp[i] = (const float*)d_in[i];
    p.out = (float*)d_out; p.ws = (unsigned char*)d_ws;
    void* args[] = {&p};
    hipError_t e = hipLaunchCooperativeKernel((const void*)fwd_kernel, dim3(grid), dim3(512), args, LDS_BYTES, stream);
    if (e != hipSuccess) fprintf(stderr, "cooperative launch failed: %s (grid %d)\n", hipGetErrorString(e), grid);
}
```
